# Optimizing an MI355X kernel written in HIP

```python
import math
import jax, jax.numpy as jnp
from jax import lax
import numpy as np

D_MODEL = 2048
BATCH = 4
SEQ = 4096
DEPTH = 1

HEAD_DIM = 64
D_RWKV = D_MODEL // 2
D_SB = D_MODEL - D_RWKV
N_RWKV_HEADS = D_RWKV // HEAD_DIM
N_SB_HEADS = D_SB // HEAD_DIM
D_IN_PROJ = 3 * D_RWKV + 3 * D_SB
DECAY_LORA = 64
AAA_LORA = 64
GATE_LORA = 160
D_FF = ((8 * D_MODEL + 3 * 256 - 1) // (3 * 256)) * 256
SB_BLOCK = 128
RMS_EPS = 1e-6
GN_EPS = 64e-5
L2_EPS = 1e-12

kernel_name = "hymba_rwkv7_stickbreaking_block"


def rms_norm(x, gain):
    xf = x.astype(jnp.float32)
    y = xf * lax.rsqrt(jnp.mean(xf * xf, axis=-1, keepdims=True) + RMS_EPS)
    return (y * gain.astype(jnp.float32)).astype(x.dtype)


def token_shift(x):
    return jnp.pad(x[:, :-1], ((0, 0), (1, 0), (0, 0)))


def rwkv7_time_mix(h, p_rkv, mu_rkv, mu_w, mu_a, mu_g, w0, w1, w2, a0, a1, a2,
                   g1, g2, k_k, k_a, r_k, ln_x_gain, ln_x_bias):
    B, T, _ = h.shape
    H, N = N_RWKV_HEADS, HEAD_DIM
    dh = token_shift(h) - h
    xw = h + dh * mu_w
    xa = h + dh * mu_a
    xg = h + dh * mu_g
    p = p_rkv + (token_shift(p_rkv) - p_rkv) * mu_rkv
    r, k, v = jnp.split(p, 3, axis=-1)
    w_log = -jax.nn.softplus(-(w0 + jnp.tanh(xw @ w1) @ w2)) - 0.5
    decay = jnp.exp(-jnp.exp(w_log.astype(jnp.float32)))
    a = jax.nn.sigmoid(a0 + (xa @ a1) @ a2)
    g = jax.nn.sigmoid(xg @ g1) @ g2
    kk = (k * k_k).reshape(B, T, H, N).astype(jnp.float32)
    kk = kk * lax.rsqrt(jnp.sum(kk * kk, axis=-1, keepdims=True) + L2_EPS)
    k = k * (1.0 + (a - 1.0) * k_a)
    rh = r.reshape(B, T, H, N)
    kh = k.reshape(B, T, H, N)
    vh = v.reshape(B, T, H, N)
    ah = a.reshape(B, T, H, N).astype(jnp.float32)
    wh = decay.reshape(B, T, H, N)

    def step(S, inp):
        r_t, w_t, k_t, v_t, rem_t, wr_t = inp
        sa = jnp.einsum('bhvk,bhk->bhv', S, rem_t)
        S = (S * w_t[:, :, None, :] + sa[..., None] * wr_t[:, :, None, :]
             + v_t[..., None] * k_t[:, :, None, :])
        y = jnp.einsum('bhvk,bhk->bhv', S, r_t)
        return S, y

    xs = tuple(jnp.moveaxis(t.astype(jnp.float32), 1, 0)
               for t in (rh, wh, kh, vh, -kk, kk * ah))
    S0 = jnp.zeros((B, H, N, N), jnp.float32)
    _, y = lax.scan(step, S0, xs)
    y = jnp.moveaxis(y, 0, 1)
    mean = jnp.mean(y, axis=-1, keepdims=True)
    var = jnp.mean(jnp.square(y - mean), axis=-1, keepdims=True)
    y = ((y - mean) * lax.rsqrt(var + GN_EPS)).reshape(B, T, D_RWKV)
    y = (y * ln_x_gain + ln_x_bias).astype(h.dtype)
    bonus = jnp.sum(rh * kh * r_k, axis=-1, keepdims=True) * vh
    return (y + bonus.reshape(B, T, D_RWKV)) * g


def stick_breaking_attention(q, k, v):
    B, H, T, d = q.shape
    nblk = T // SB_BLOCK
    qb = q.reshape(B, H, nblk, SB_BLOCK, d).transpose(2, 0, 1, 3, 4)
    kpos = jnp.arange(T)
    inv_sqrt_d = 1.0 / math.sqrt(d)

    def block(args):
        qi, i = args
        z = jnp.einsum('bhqd,bhkd->bhqk', qi, k).astype(jnp.float32) * inv_sqrt_d
        qpos = i * SB_BLOCK + jnp.arange(SB_BLOCK)
        causal = kpos[None, :] < qpos[:, None]
        log_1m_beta = jnp.where(causal, -jax.nn.softplus(z), 0.0)
        tail = lax.cumsum(log_1m_beta, axis=3, reverse=True) - log_1m_beta
        log_a = jax.nn.log_sigmoid(z) + tail
        attn = jnp.where(causal, jnp.exp(log_a), 0.0)
        return jnp.einsum('bhqk,bhkd->bhqd', attn.astype(v.dtype), v)

    out = lax.map(block, (qb, jnp.arange(nblk)))
    return out.transpose(1, 2, 0, 3, 4).reshape(B, H, T, d)


def setup_inputs(seed: int = 0) -> dict:
    key = jax.random.key(seed)
    ks = jax.random.split(key, 32)
    L = DEPTH

    def nrm(k, shape, scale):
        return jax.random.normal(k, shape, jnp.float32) * scale

    def uni(k, shape, lo=0.0, hi=1.0):
        return jax.random.uniform(k, shape, jnp.float32, minval=lo, maxval=hi)

    Dm = D_MODEL
    return {
        "x": nrm(ks[0], (BATCH, SEQ, Dm), 1.0),
        "c": nrm(ks[1], (BATCH, Dm), 1.0),
        "w_ada": nrm(ks[2], (L, Dm, 6 * Dm), 0.5 * Dm ** -0.5),
        "b_ada": nrm(ks[3], (L, 6 * Dm), 0.02),
        "norm1_gain": 1.0 + nrm(ks[4], (L, Dm), 0.05),
        "norm2_gain": 1.0 + nrm(ks[5], (L, Dm), 0.05),
        "w_in": nrm(ks[6], (L, Dm, D_IN_PROJ), Dm ** -0.5),
        "mu_rkv": uni(ks[7], (L, 3 * D_RWKV)),
        "mu_w": uni(ks[8], (L, Dm)),
        "mu_a": uni(ks[9], (L, Dm)),
        "mu_g": uni(ks[10], (L, Dm)),
        "w0": uni(ks[11], (L, D_RWKV), -5.5, -0.5),
        "w1": nrm(ks[12], (L, Dm, DECAY_LORA), Dm ** -0.5),
        "w2": nrm(ks[13], (L, DECAY_LORA, D_RWKV), 0.3 * DECAY_LORA ** -0.5),
        "a0": nrm(ks[14], (L, D_RWKV), 0.1),
        "a1": nrm(ks[15], (L, Dm, AAA_LORA), Dm ** -0.5),
        "a2": nrm(ks[16], (L, AAA_LORA, D_RWKV), 0.3 * AAA_LORA ** -0.5),
        "g1": nrm(ks[17], (L, Dm, GATE_LORA), Dm ** -0.5),
        "g2": nrm(ks[18], (L, GATE_LORA, D_RWKV), GATE_LORA ** -0.5),
        "k_k": 0.85 + nrm(ks[19], (L, D_RWKV), 0.05),
        "k_a": 1.0 + nrm(ks[20], (L, D_RWKV), 0.05),
        "r_k": nrm(ks[21], (L, N_RWKV_HEADS, HEAD_DIM), 0.1),
        "ln_x_gain": 1.0 + nrm(ks[22], (L, D_RWKV), 0.05),
        "ln_x_bias": nrm(ks[23], (L, D_RWKV), 0.02),
        "q_norm_gain": 1.0 + nrm(ks[24], (L, HEAD_DIM), 0.05),
        "k_norm_gain": 1.0 + nrm(ks[25], (L, HEAD_DIM), 0.05),
        "w_out": nrm(ks[26], (L, Dm, Dm), Dm ** -0.5),
        "w_gate_up": nrm(ks[27], (L, Dm, 2 * D_FF), Dm ** -0.5),
        "w_down": nrm(ks[28], (L, D_FF, Dm), D_FF ** -0.5),
    }


def reference(x, c, w_ada, b_ada, norm1_gain, norm2_gain, w_in, mu_rkv, mu_w, mu_a,
              mu_g, w0, w1, w2, a0, a1, a2, g1, g2, k_k, k_a, r_k, ln_x_gain,
              ln_x_bias, q_norm_gain, k_norm_gain, w_out, w_gate_up, w_down):
    B, T, _ = x.shape
    c_act = jax.nn.silu(c)
    for l in range(DEPTH):
        mod = c_act @ w_ada[l] + b_ada[l]
        sh1, sc1, gt1, sh2, sc2, gt2 = [m[:, None, :] for m in jnp.split(mod, 6, axis=-1)]

        h = rms_norm(x, norm1_gain[l]) * (1.0 + sc1) + sh1
        p = h @ w_in[l]
        p_rkv, p_sb = p[..., :3 * D_RWKV], p[..., 3 * D_RWKV:]

        y_rwkv = rwkv7_time_mix(h, p_rkv, mu_rkv[l], mu_w[l], mu_a[l], mu_g[l],
                                w0[l], w1[l], w2[l], a0[l], a1[l], a2[l], g1[l], g2[l],
                                k_k[l], k_a[l], r_k[l], ln_x_gain[l], ln_x_bias[l])

        q, k, v = jnp.split(p_sb, 3, axis=-1)
        q = rms_norm(q.reshape(B, T, N_SB_HEADS, HEAD_DIM), q_norm_gain[l])
        k = rms_norm(k.reshape(B, T, N_SB_HEADS, HEAD_DIM), k_norm_gain[l])
        v = v.reshape(B, T, N_SB_HEADS, HEAD_DIM)
        y_sb = stick_breaking_attention(q.transpose(0, 2, 1, 3), k.transpose(0, 2, 1, 3),
                                        v.transpose(0, 2, 1, 3))
        y_sb = y_sb.transpose(0, 2, 1, 3).reshape(B, T, D_SB)

        mix = jnp.concatenate([y_rwkv, y_sb], axis=-1) @ w_out[l]
        x = x + gt1 * mix

        h2 = rms_norm(x, norm2_gain[l]) * (1.0 + sc2) + sh2
        gate, up = jnp.split(h2 @ w_gate_up[l], 2, axis=-1)
        x = x + gt2 * ((jax.nn.silu(gate) * up) @ w_down[l])
    return x
```

```cpp
#include <hip/hip_runtime.h>
#include <hip/hip_cooperative_groups.h>
#include <cstdio>
#include <cstdint>
namespace cg = cooperative_groups;

#define LAS __attribute__((address_space(3)))
typedef unsigned short bf16;
typedef short bf16x8 __attribute__((ext_vector_type(8)));
typedef _Float16 half8 __attribute__((ext_vector_type(8)));
typedef float f32x4 __attribute__((ext_vector_type(4)));
typedef float f32x2 __attribute__((ext_vector_type(2)));
typedef float f32x16 __attribute__((ext_vector_type(16)));
typedef unsigned u32x4 __attribute__((ext_vector_type(4)));
typedef unsigned u32x2 __attribute__((ext_vector_type(2)));

constexpr int BATCH = 4, SEQ = 4096, DM = 2048, MTOK = BATCH * SEQ, NH = 16, HD = 64, DR = 1024, DFF = 5632;
constexpr int NLORA = 288, NP1 = 6912, KH = 384, NMOD = 6 * DM;
constexpr float LOG2E = 1.4426950408889634f;

constexpr size_t MiB = 1u << 20;
constexpr size_t WS_CTL = 0, CTL_ZERO_BYTES = 1 * MiB, WS_BAR = 512 * 1024;
constexpr size_t WS_W1T = 1 * MiB, WS_WOT = 28 * MiB, WS_WGUT = 36 * MiB, WS_WDT = 80 * MiB, WS_W2T = 102 * MiB;
constexpr size_t WS_H = 105 * MiB, WS_PRKV = 169 * MiB, WS_PSB = 265 * MiB, WS_PLORA = 361 * MiB, WS_HID = 385 * MiB, WS_L2O = 397 * MiB, WS_BS = 493 * MiB, WS_END = 496 * MiB;
constexpr size_t WS_ACT = WS_PRKV, WS_YCAT = WS_H;
constexpr size_t WS_SV = WS_PLORA;
constexpr size_t WS_AB = 494 * MiB;
constexpr size_t SCAN_ARR = (size_t)MTOK * DR;
constexpr int LDS_BYTES = 132096;
#ifndef MK_PROBE
#define MK_PROBE 0
#endif
constexpr int PROBE = MK_PROBE;

__device__ __forceinline__ unsigned f2bf(float f) { unsigned u = __builtin_bit_cast(unsigned, f); return (u + 0x7fffu + ((u >> 16) & 1u)) >> 16; }
__device__ __forceinline__ unsigned pk2(float lo, float hi) { unsigned r; asm volatile("v_cvt_pk_bf16_f32 %0, %1, %2" : "=v"(r) : "v"(lo), "v"(hi)); return r; }
__device__ __forceinline__ float bflo(unsigned u) { return __builtin_bit_cast(float, u << 16); }
__device__ __forceinline__ float bfhi(unsigned u) { return __builtin_bit_cast(float, u & 0xffff0000u); }
__device__ __forceinline__ f32x4 bf4(u32x2 u) { return (f32x4){bflo(u.x), bfhi(u.x), bflo(u.y), bfhi(u.y)}; }
__device__ __forceinline__ u32x2 pk4(f32x4 v) { u32x2 r; r.x = pk2(v[0], v[1]); r.y = pk2(v[2], v[3]); return r; }
__device__ __forceinline__ float fexp2(float x) { return __builtin_amdgcn_exp2f(x); }
__device__ __forceinline__ float flog2(float x) { return __builtin_amdgcn_logf(x); }
__device__ __forceinline__ float frcp(float x) { return __builtin_amdgcn_rcpf(x); }
__device__ __forceinline__ float sigmoidf_(float x) { return frcp(1.0f + fexp2(-x * LOG2E)); }
template <int CTRL> __device__ __forceinline__ float dppf(float x) { return __builtin_bit_cast(float, __builtin_amdgcn_update_dpp(0, __builtin_bit_cast(int, x), CTRL, 0xf, 0xf, true)); }
__device__ __forceinline__ float allsum16(float x) { x += dppf<0xB1>(x); x += dppf<0x4E>(x); x += dppf<0x141>(x); x += dppf<0x140>(x); return x; }
__device__ __forceinline__ float wave_sum(float v) {
#pragma unroll
    for (int o = 1; o < 64; o <<= 1) v += __shfl_xor(v, o);
    return v;
}

__device__ __forceinline__ int tid_opaque() { int t = threadIdx.x; asm volatile("" : "+v"(t)); return t; }
#define PHASE_IDS() const int tid = tid_opaque(), lane = tid & 63; const int gw = blockIdx.x * 8 + wave, gtid = blockIdx.x * 512 + tid; (void)lane; (void)gw; (void)gtid
__device__ __forceinline__ unsigned xb_ld(unsigned* p)              { return __hip_atomic_load(p, __ATOMIC_RELAXED, __HIP_MEMORY_SCOPE_AGENT); }
__device__ __forceinline__ unsigned xb_add(unsigned* p, unsigned v) { return __hip_atomic_fetch_add(p, v, __ATOMIC_RELAXED, __HIP_MEMORY_SCOPE_AGENT); }
namespace pg8 {
typedef unsigned short bf16_t;
constexpr int BM = 256, BK = 64, HALF = 128, HTB = HALF * BK * 2, STAGE_BYTES = 8 * HTB, NXCD = 8, WGM = 8;
__host__ __device__ __forceinline__ int lds_byte(int r, int c) { const int st = (r >> 4) * 2 + (c >> 5), rr = r & 15, cc = c & 31, ob = rr * 64 + cc * 2; return st * 1024 + (ob ^ (((ob >> 9) & 1) << 5)); }
__host__ __device__ __forceinline__ void stage_rc(int b, int& R, int& C) { const int st = b / 1024, sb = b % 1024, swz = sb ^ (((sb >> 9) & 1) << 5); R = (st >> 1) * 16 + swz / 64; C = (st & 1) * 32 + (swz % 64) / 2; }
__host__ __device__ __forceinline__ int perm32(int rho) { const int n = rho >> 4, i = rho & 15; return 8 * (i >> 2) + 4 * n + (i & 3); }
struct Unit { int pm, pn; };
struct Gemm { const bf16_t* A; const bf16_t* Bt; int M, N, K; int lda, ldb; };
struct StaticOrder {
    int nM, nN, nwg, G, c;
    __host__ __device__ void init(int M, int N, int G_, int c_) { nM = M / BM; nN = N / BM; nwg = nM * nN; G = G_; c = c_; }
    __host__ __device__ bool next(int i, Unit& u) const {
        const long L = (long)i * G + c; if (L >= nwg) return false;
        int wgid = (int)L; { const int q = nwg / NXCD, r = nwg % NXCD, xcd = wgid % NXCD, off = wgid / NXCD; wgid = (xcd < r ? xcd * (q + 1) : r * (q + 1) + (xcd - r) * q) + off; }
        const int nig = WGM * nN, gid = wgid / nig, fm = gid * WGM, gsz = (nM - fm) < WGM ? (nM - fm) : WGM;
        u.pm = fm + ((wgid % nig) % gsz); u.pn = (wgid % nig) / gsz; return true;
    }
    __device__ __forceinline__ void a_ready(const Unit&) const {}
    __device__ __forceinline__ void done(const Unit&) const {}
};

struct EpiStore {
    static constexpr bool PERM = true, AFTER_DRAIN = false;
    bf16_t* O0; bf16_t* O1; bf16_t* O2; int t1, t2; int ld0, ld1, ld2;
    __device__ __forceinline__ void operator()(const f32x4 (&acc)[2][2][4][2], const Unit& u, int wr, int wc, int fr, int fq) const {
        bf16_t* base; int ldc, pn = u.pn;
        if (pn < t1) { base = O0; ldc = ld0; } else if (pn < t2) { base = O1; ldc = ld1; pn -= t1; } else { base = O2; ldc = ld2; pn -= t2; }
        const int row0 = u.pm * BM + wr * 64 + fr, col0 = pn * BM + wc * 32 + 8 * fq;
#pragma unroll
        for (int ai = 0; ai < 2; ++ai)
#pragma unroll
            for (int m = 0; m < 4; ++m) { bf16_t* rowp = base + (size_t)(row0 + ai * HALF + m * 16) * ldc + col0;
#pragma unroll
                for (int bj = 0; bj < 2; ++bj) { const f32x4 v0 = acc[ai][bj][m][0], v1 = acc[ai][bj][m][1];
                    u32x4 w; w.x = pk2(v0[0], v0[1]); w.y = pk2(v0[2], v0[3]); w.z = pk2(v1[0], v1[1]); w.w = pk2(v1[2], v1[3]);
                    *(u32x4*)(rowp + bj * HALF) = w; } }
    }
};
struct EpiRes {
    static constexpr bool PERM = true, AFTER_DRAIN = false;
    const float* base; float* out; const float* gate;
    __device__ __forceinline__ void operator()(const f32x4 (&acc)[2][2][4][2], const Unit& u, int wr, int wc, int fr, int fq) const {
        const int row0 = u.pm * BM + wr * 64 + fr, col0 = u.pn * BM + wc * 32 + 8 * fq, b = u.pm >> 4;
#pragma unroll
        for (int bj = 0; bj < 2; ++bj) { const int c = col0 + bj * HALF;
            const f32x4 gv0 = *(const f32x4*)(gate + (size_t)b * NMOD + c), gv1 = *(const f32x4*)(gate + (size_t)b * NMOD + c + 4);
#pragma unroll
            for (int ai = 0; ai < 2; ++ai) { f32x4 bs[4][2];
#pragma unroll
                for (int m = 0; m < 4; ++m) { const float* p = base + (size_t)(row0 + ai * HALF + m * 16) * DM + c; bs[m][0] = *(const f32x4*)p; bs[m][1] = *(const f32x4*)(p + 4); }
#pragma unroll
                for (int m = 0; m < 4; ++m) { float* o = out + (size_t)(row0 + ai * HALF + m * 16) * DM + c;
                    *(f32x4*)o = bs[m][0] + gv0 * acc[ai][bj][m][0]; *(f32x4*)(o + 4) = bs[m][1] + gv1 * acc[ai][bj][m][1]; }
                asm volatile("" ::: "memory"); } }
    }
};
struct EpiResH2 {
    static constexpr bool PERM = true, AFTER_DRAIN = false;
    const float* base; float* out; const float* mod; const float* g2; bf16_t* h2; float* rowss;
    __device__ __forceinline__ void operator()(const f32x4 (&acc)[2][2][4][2], const Unit& u, int wr, int wc, int fr, int fq) const {
        const int row0 = u.pm * BM + wr * 64 + fr, col0 = u.pn * BM + wc * 32 + 8 * fq; const float* mb = mod + (size_t)(u.pm >> 4) * NMOD;
        float ssacc[2][4];
#pragma unroll
        for (int ai = 0; ai < 2; ++ai)
#pragma unroll
            for (int m = 0; m < 4; ++m) ssacc[ai][m] = 0.f;
#pragma unroll
        for (int bj = 0; bj < 2; ++bj) { const int c = col0 + bj * HALF;
            const f32x4 gv0 = *(const f32x4*)(mb + 2 * DM + c), gv1 = *(const f32x4*)(mb + 2 * DM + c + 4);
            const f32x4 gm0 = *(const f32x4*)(g2 + c) * (*(const f32x4*)(mb + 4 * DM + c) + 1.0f), gm1 = *(const f32x4*)(g2 + c + 4) * (*(const f32x4*)(mb + 4 * DM + c + 4) + 1.0f);
#pragma unroll
            for (int ai = 0; ai < 2; ++ai) { f32x4 bs[4][2];
#pragma unroll
                for (int m = 0; m < 4; ++m) { const float* p = base + (size_t)(row0 + ai * HALF + m * 16) * DM + c; bs[m][0] = *(const f32x4*)p; bs[m][1] = *(const f32x4*)(p + 4); }
#pragma unroll
                for (int m = 0; m < 4; ++m) { const size_t off = (size_t)(row0 + ai * HALF + m * 16) * DM + c;
                    const f32x4 x0 = bs[m][0] + gv0 * acc[ai][bj][m][0], x1 = bs[m][1] + gv1 * acc[ai][bj][m][1];
                    *(f32x4*)(out + off) = x0; *(f32x4*)(out + off + 4) = x1;
                    const u32x2 p0 = pk4(x0 * gm0), p1 = pk4(x1 * gm1); *(u32x4*)(h2 + off) = (u32x4){p0.x, p0.y, p1.x, p1.y};
                    ssacc[ai][m] += ((x0[0] * x0[0] + x0[1] * x0[1]) + (x0[2] * x0[2] + x0[3] * x0[3])) + ((x1[0] * x1[0] + x1[1] * x1[1]) + (x1[2] * x1[2] + x1[3] * x1[3])); }
                asm volatile("" ::: "memory"); } }
#pragma unroll
        for (int ai = 0; ai < 2; ++ai)
#pragma unroll
            for (int m = 0; m < 4; ++m) { float sv = ssacc[ai][m]; sv += __shfl_xor(sv, 16); sv += __shfl_xor(sv, 32);
                if (fq == 0) atomicAdd(rowss + row0 + ai * HALF + m * 16, sv); }
    }
};
struct EpiSwiGLU {
    static constexpr bool PERM = true, AFTER_DRAIN = false;
    bf16_t* O; const float* rowss; const float* c2;
    __device__ __forceinline__ void operator()(const f32x4 (&acc)[2][2][4][2], const Unit& u, int wr, int wc, int fr, int fq) const {
        const int row0 = u.pm * BM + wr * 64 + fr, col0 = u.pn * HALF + wc * 32 + 8 * fq; const float* cb = c2 + (size_t)(u.pm >> 4) * (2 * DFF) + col0;
        const f32x4 cg[2] = {*(const f32x4*)cb, *(const f32x4*)(cb + 4)}, cu[2] = {*(const f32x4*)(cb + DFF), *(const f32x4*)(cb + DFF + 4)};
#pragma unroll
        for (int ai = 0; ai < 2; ++ai)
#pragma unroll
            for (int m = 0; m < 4; ++m) { bf16_t* rowp = O + (size_t)(row0 + ai * HALF + m * 16) * DFF + col0; float v[8];
                const float rs = __builtin_amdgcn_rsqf(rowss[row0 + ai * HALF + m * 16] * (1.0f / DM) + 1e-6f);
#pragma unroll
                for (int n = 0; n < 2; ++n)
#pragma unroll
                    for (int j = 0; j < 4; ++j) { const float g = __builtin_fmaf(rs, acc[ai][0][m][n][j], cg[n][j]), up = __builtin_fmaf(rs, acc[ai][1][m][n][j], cu[n][j]); v[4 * n + j] = g * sigmoidf_(g) * up; }
                u32x4 w; w.x = pk2(v[0], v[1]); w.y = pk2(v[2], v[3]); w.z = pk2(v[4], v[5]); w.w = pk2(v[6], v[7]);
                *(u32x4*)rowp = w; }
    }
};

template <class Epi, class Sched, bool ALIGN_EPI = false, bool SP2 = false>
__device__ __forceinline__ void gemm_phase(LAS unsigned char* lds, const Gemm g, const Sched& S, const Epi& E) {
    const int tid = threadIdx.x, wid = __builtin_amdgcn_readfirstlane(tid >> 6), lane = tid & 63, wr = wid >> 2, wc = wid & 3, fr = lane & 15, fq = lane >> 4;
    const int K = g.K, nt = K / BK, lda = g.lda ? g.lda : K, ldb = g.ldb ? g.ldb : K;
    unsigned voffA[2], voffB[2];
#pragma unroll
    for (int i = 0; i < 2; ++i) { int R, C; stage_rc(tid * 16 + i * 8192, R, C); const int Rb = Epi::PERM ? ((R & ~31) + perm32(R & 31)) : R;
        voffA[i] = (unsigned)(R * lda + C) * 2u; voffB[i] = (unsigned)(Rb * ldb + C) * 2u; }
    const size_t kstep = (size_t)(BK * 2);
    const size_t hstepA = (size_t)HALF * lda * 2, hstepB = (size_t)HALF * ldb * 2;
    const size_t tstepA = 2 * hstepA, tstepB = 2 * hstepB;
    const unsigned ldsw = (unsigned)wid * 1024u;
    const int aoff = lds_byte(wr * 64 + fr, fq * 8), boff = lds_byte(wc * 32 + fr, fq * 8);
#define PG8_SA(b, h) (((b) * 2 + (h)) * HTB)
#define PG8_SB(b, h) ((4 + (b) * 2 + (h)) * HTB)
#define PG8_STAGE(bufoff, gbase, voff) do { _Pragma("unroll") for (int _i = 0; _i < 2; ++_i) \
        __builtin_amdgcn_global_load_lds((const unsigned*)((const char*)(gbase) + (voff)[_i]), (LAS unsigned*)(lds + (bufoff) + ldsw + _i * 8192), 16, 0, 0); } while (0)
#define PG8_LDA(dst, b, h) do { _Pragma("unroll") for (int m = 0; m < 4; ++m) _Pragma("unroll") for (int k = 0; k < 2; ++k) dst[m][k] = *(const LAS bf16x8*)(lds + PG8_SA(b, h) + aoff + m * 2048 + k * 1024); } while (0)
#define PG8_LDB(dst, b, h) do { _Pragma("unroll") for (int n = 0; n < 2; ++n) _Pragma("unroll") for (int k = 0; k < 2; ++k) dst[n][k] = *(const LAS bf16x8*)(lds + PG8_SB(b, h) + boff + n * 2048 + k * 1024); } while (0)
#define PG8_MMA(ai, bj, At, Bt) do { __builtin_amdgcn_s_setprio(1); _Pragma("unroll") for (int m = 0; m < 4; ++m) _Pragma("unroll") for (int n = 0; n < 2; ++n) _Pragma("unroll") for (int k = 0; k < 2; ++k) \
        acc[ai][bj][m][n] = __builtin_amdgcn_mfma_f32_16x16x32_bf16(Bt[n][k], At[m][k], acc[ai][bj][m][n], 0, 0, 0); __builtin_amdgcn_s_setprio(0); } while (0)
#define PG8_WAIT_V(n) asm volatile("s_waitcnt vmcnt(" #n ")" ::: "memory")
#define PG8_WAIT_L(n) asm volatile("s_waitcnt lgkmcnt(" #n ")" ::: "memory")
#define PG8_BAR __builtin_amdgcn_s_barrier()
#define PG8_SCHED __builtin_amdgcn_sched_barrier(0)
    Unit cur, nxt; int ui = 0;
    if (!S.next(0, cur)) return;
    f32x4 acc[2][2][4][2];
#pragma unroll
    for (int a = 0; a < 2; ++a)
#pragma unroll
        for (int b = 0; b < 2; ++b)
#pragma unroll
            for (int m = 0; m < 4; ++m)
#pragma unroll
                for (int n = 0; n < 2; ++n) acc[a][b][m][n] = (f32x4){0.f, 0.f, 0.f, 0.f};
    bf16x8 At[4][2], B0[2][2], B1[2][2];
    const char* cA = (const char*)g.A + (size_t)cur.pm * tstepA; const char* cB = (const char*)g.Bt + (size_t)cur.pn * tstepB;
    S.a_ready(cur);
    if constexpr (SP2) {
        PG8_STAGE(PG8_SB(0, 0), cB, voffB); PG8_STAGE(PG8_SB(0, 1), cB + hstepB, voffB); PG8_STAGE(PG8_SA(0, 0), cA, voffA); PG8_STAGE(PG8_SA(0, 1), cA + hstepA, voffA);
        if (wr == 1) PG8_BAR;
        PG8_WAIT_V(2); PG8_BAR;
        PG8_STAGE(PG8_SB(1, 0), cB + kstep, voffB); PG8_STAGE(PG8_SA(1, 0), cA + kstep, voffA); PG8_STAGE(PG8_SB(1, 1), cB + hstepB + kstep, voffB);
        PG8_WAIT_V(6); PG8_BAR;
    } else {
        PG8_STAGE(PG8_SB(0, 0), cB, voffB); PG8_STAGE(PG8_SA(0, 0), cA, voffA); PG8_STAGE(PG8_SB(0, 1), cB + hstepB, voffB); PG8_STAGE(PG8_SA(0, 1), cA + hstepA, voffA);
        if (wr == 1) PG8_BAR;
        PG8_WAIT_V(4); PG8_BAR;
        PG8_STAGE(PG8_SB(1, 0), cB + kstep, voffB); PG8_STAGE(PG8_SA(1, 0), cA + kstep, voffA); PG8_STAGE(PG8_SB(1, 1), cB + hstepB + kstep, voffB);
        PG8_WAIT_V(6); PG8_BAR;
    }
    for (;;) {
        const bool has_next = S.next(ui + 1, nxt);
        const char* nA = has_next ? (const char*)g.A + (size_t)nxt.pm * tstepA : cA; const char* nB = has_next ? (const char*)g.Bt + (size_t)nxt.pn * tstepB : cB;
        for (int t = 0; t < nt; t += 2) {
            const bool last = (t == nt - 2);
            const char* a1 = cA + (size_t)(t + 1) * kstep;
            const char* a2 = last ? nA : cA + (size_t)(t + 2) * kstep; const char* b2 = last ? nB : cB + (size_t)(t + 2) * kstep;
            const char* a3 = a2 + kstep; const char* b3 = b2 + kstep;
            if (last && has_next) S.a_ready(nxt);
            if constexpr (SP2) {
            PG8_LDB(B0, 0, 0); PG8_LDB(B1, 0, 1); PG8_SCHED; PG8_LDA(At, 0, 0); PG8_STAGE(PG8_SA(1, 1), a1 + hstepA, voffA);
            PG8_WAIT_V(8); PG8_WAIT_L(0); PG8_BAR; PG8_MMA(0, 0, At, B0); PG8_MMA(0, 1, At, B1); PG8_BAR; PG8_SCHED;
            PG8_LDA(At, 0, 1); PG8_STAGE(PG8_SB(0, 0), b2, voffB); PG8_STAGE(PG8_SB(0, 1), b2 + hstepB, voffB); PG8_STAGE(PG8_SA(0, 0), a2, voffA);
            PG8_WAIT_V(8); PG8_WAIT_L(0); PG8_BAR; PG8_MMA(1, 0, At, B0); PG8_MMA(1, 1, At, B1); PG8_BAR; PG8_SCHED;
            PG8_LDB(B0, 1, 0); PG8_LDB(B1, 1, 1); PG8_SCHED; PG8_LDA(At, 1, 0); PG8_STAGE(PG8_SA(0, 1), a2 + hstepA, voffA);
            PG8_WAIT_V(8); PG8_WAIT_L(0); PG8_BAR; PG8_MMA(0, 0, At, B0); PG8_MMA(0, 1, At, B1); PG8_BAR; PG8_SCHED;
            PG8_LDA(At, 1, 1); PG8_STAGE(PG8_SB(1, 0), b3, voffB); PG8_STAGE(PG8_SB(1, 1), b3 + hstepB, voffB); PG8_STAGE(PG8_SA(1, 0), a3, voffA);
            PG8_WAIT_V(8); PG8_WAIT_L(0); PG8_BAR; PG8_MMA(1, 0, At, B0); PG8_MMA(1, 1, At, B1); PG8_BAR; PG8_SCHED;
            } else {
            PG8_LDB(B0, 0, 0); PG8_SCHED; PG8_LDA(At, 0, 0); PG8_STAGE(PG8_SA(1, 1), a1 + hstepA, voffA);
            PG8_WAIT_L(8); PG8_BAR; PG8_WAIT_L(0); PG8_MMA(0, 0, At, B0); PG8_BAR; PG8_SCHED;
            PG8_LDB(B1, 0, 1); PG8_STAGE(PG8_SB(0, 0), b2, voffB);
            PG8_BAR; PG8_WAIT_L(0); PG8_MMA(0, 1, At, B1); PG8_BAR;
            PG8_LDA(At, 0, 1); PG8_STAGE(PG8_SA(0, 0), a2, voffA);
            PG8_BAR; PG8_WAIT_L(0); PG8_MMA(1, 0, At, B0); PG8_BAR; PG8_SCHED;
            PG8_STAGE(PG8_SB(0, 1), b2 + hstepB, voffB);
            PG8_WAIT_V(6); PG8_BAR; PG8_MMA(1, 1, At, B1); PG8_BAR;
            PG8_LDB(B0, 1, 0); PG8_SCHED; PG8_LDA(At, 1, 0); PG8_STAGE(PG8_SA(0, 1), a2 + hstepA, voffA);
            PG8_WAIT_L(8); PG8_BAR; PG8_WAIT_L(0); PG8_MMA(0, 0, At, B0); PG8_BAR; PG8_SCHED;
            PG8_LDB(B1, 1, 1); PG8_STAGE(PG8_SB(1, 0), b3, voffB);
            PG8_BAR; PG8_WAIT_L(0); PG8_MMA(0, 1, At, B1); PG8_BAR;
            PG8_LDA(At, 1, 1); PG8_STAGE(PG8_SA(1, 0), a3, voffA);
            PG8_BAR; PG8_WAIT_L(0); PG8_MMA(1, 0, At, B0); PG8_BAR; PG8_SCHED;
            PG8_STAGE(PG8_SB(1, 1), b3 + hstepB, voffB);
            PG8_WAIT_V(6); PG8_BAR; PG8_MMA(1, 1, At, B1); PG8_BAR;
            }
        }
        if constexpr (ALIGN_EPI) { if (wr == 0) PG8_BAR; }
        if constexpr (!Epi::AFTER_DRAIN) { E(acc, cur, wr, wc, fr, fq); S.done(cur); }
        if (!has_next) break;
#pragma unroll
        for (int a = 0; a < 2; ++a)
#pragma unroll
            for (int b = 0; b < 2; ++b)
#pragma unroll
                for (int m = 0; m < 4; ++m)
#pragma unroll
                    for (int n = 0; n < 2; ++n) acc[a][b][m][n] = (f32x4){0.f, 0.f, 0.f, 0.f};
        cur = nxt; cA = nA; cB = nB; ++ui;
        if constexpr (ALIGN_EPI) { if (wr == 1) PG8_BAR; }
    }
    PG8_WAIT_V(0);
    if constexpr (!ALIGN_EPI) { if (wr == 0) PG8_BAR; }
    PG8_BAR;
#undef PG8_SA
#undef PG8_SB
#undef PG8_STAGE
#undef PG8_LDA
#undef PG8_LDB
#undef PG8_MMA
#undef PG8_WAIT_V
#undef PG8_WAIT_L
#undef PG8_BAR
#undef PG8_SCHED
}
}

__device__ __forceinline__ void p0_transpose_item(const float* W, int N, bf16* WT, int ldo, int drow0, LAS float* scr, int kb, int nb, int lane, const float* mu, int mode) {
    const int k0 = 64 * kb, n0 = 32 * nb;
    float wv[32];
#pragma unroll
    for (int i = 0; i < 32; ++i) wv[i] = __builtin_nontemporal_load(W + (size_t)(k0 + 2 * i + (lane >> 5)) * N + n0 + (lane & 31));
#pragma unroll
    for (int i = 0; i < 32; ++i) { const int kk = 2 * i + (lane >> 5); float v = wv[i];
        if (mode) { const float m = mu[k0 + kk]; v *= (mode == 1) ? (1.0f - m) : m; }
        scr[kk * 33 + (lane & 31)] = v; }
    asm volatile("s_waitcnt lgkmcnt(0)" ::: "memory");
    const int c = lane & 7;
#pragma unroll
    for (int j = 0; j < 4; ++j) { const int n = (lane >> 3) + 8 * j; const LAS float* s = scr + (8 * c) * 33 + n;
        u32x4 o; o.x = pk2(s[0 * 33], s[1 * 33]); o.y = pk2(s[2 * 33], s[3 * 33]); o.z = pk2(s[4 * 33], s[5 * 33]); o.w = pk2(s[6 * 33], s[7 * 33]);
        *(u32x4*)(WT + (size_t)(drow0 + n) * ldo + k0 + 8 * c) = o; }
    asm volatile("s_waitcnt lgkmcnt(0)" ::: "memory");
}
__device__ __forceinline__ void modnorm_row2(const float* xrow, bf16* orow, const float* gain, const float* sc, const float* sh, int lane) {
    const f32x4* xr = (const f32x4*)xrow + lane;
    f32x4 v[2][8]; float s0 = 0.f, s1 = 0.f;
#pragma unroll
    for (int j = 0; j < 8; ++j) { v[0][j] = __builtin_nontemporal_load(xr + 64 * j); v[1][j] = __builtin_nontemporal_load(xr + 512 + 64 * j); }
#pragma unroll
    for (int j = 0; j < 8; ++j) { s0 += (v[0][j][0] * v[0][j][0] + v[0][j][1] * v[0][j][1]) + (v[0][j][2] * v[0][j][2] + v[0][j][3] * v[0][j][3]);
                                  s1 += (v[1][j][0] * v[1][j][0] + v[1][j][1] * v[1][j][1]) + (v[1][j][2] * v[1][j][2] + v[1][j][3] * v[1][j][3]); }
    const float r0 = __builtin_amdgcn_rsqf(wave_sum(s0) * (1.0f / DM) + 1e-6f), r1 = __builtin_amdgcn_rsqf(wave_sum(s1) * (1.0f / DM) + 1e-6f);
    u32x2* o8 = (u32x2*)orow + lane;
#pragma unroll
    for (int j = 0; j < 8; ++j) { const f32x4 gm = ((const f32x4*)gain)[lane + 64 * j] * (((const f32x4*)sc)[lane + 64 * j] + 1.0f), b = ((const f32x4*)sh)[lane + 64 * j];
        o8[64 * j] = pk4(v[0][j] * r0 * gm + b); o8[512 + 64 * j] = pk4(v[1][j] * r1 * gm + b); }
}

__device__ __forceinline__ void late_weight_copies(const float* w_out, const float* w_gu, const float* w_dn, bf16* WOT, bf16* WGUT, bf16* WDT, LAS float* scr, int lane, int first, int stride) {
    constexpr int I_O = 32 * 64, I_GU = 32 * 352, I_DN = 88 * 64;
    for (int it = first; it < I_O + I_GU + I_DN; it += stride) { int r = it;
        if (r < I_O) { p0_transpose_item(w_out, DM, WOT, DM, 32 * (r % 64), scr, r / 64, r % 64, lane, nullptr, 0); continue; } r -= I_O;
        if (r < I_GU) { const int nb = r % 352, n0 = 32 * nb; const int drow = (n0 < DFF) ? ((n0 / 128) * 256 + n0 % 128) : (((n0 - DFF) / 128) * 256 + 128 + (n0 - DFF) % 128);
            p0_transpose_item(w_gu, 2 * DFF, WGUT, DM, drow, scr, r / 352, nb, lane, nullptr, 0); continue; }
        r -= I_GU;
        p0_transpose_item(w_dn, DM, WDT, DFF, 32 * (r % 64), scr, r / 64, r % 64, lane, nullptr, 0); }
}

__device__ __forceinline__ void sh2_gemv(const float* mod, const float* w_gu, float* c2, int first, int stride) {
    for (int it = first; it < 32 * 2816; it += stride) { const int kc = it / 2816, n4 = it % 2816;
        f32x4 a0 = {0.f, 0.f, 0.f, 0.f}, a1 = a0, a2 = a0, a3 = a0;
        for (int k0 = 64 * kc; k0 < 64 * kc + 64; k0 += 8) { f32x4 wv[8];
#pragma unroll
            for (int u = 0; u < 8; ++u) wv[u] = *(const f32x4*)(w_gu + (size_t)(k0 + u) * (2 * DFF) + 4 * n4);
#pragma unroll
            for (int u = 0; u < 8; ++u) { const float* sp = mod + 3 * DM + k0 + u; a0 += wv[u] * sp[0]; a1 += wv[u] * sp[NMOD]; a2 += wv[u] * sp[2 * NMOD]; a3 += wv[u] * sp[3 * NMOD]; } }
#pragma unroll
        for (int j = 0; j < 4; ++j) { atomicAdd(c2 + 4 * n4 + j, a0[j]); atomicAdd(c2 + 2 * DFF + 4 * n4 + j, a1[j]); atomicAdd(c2 + 4 * DFF + 4 * n4 + j, a2[j]); atomicAdd(c2 + 6 * DFF + 4 * n4 + j, a3[j]); } }
}

struct PrepPtrs { const bf16* PRKV; bf16* L2O; bf16* SR; bf16* SKT; bf16* SWR; bf16* SREM; bf16* SV; float* BS; const float* mu; const float* pw0; const float* pa0; const float* pkk; const float* pka; const float* prk; };
__device__ __forceinline__ void rwkv_prep(const PrepPtrs& P, int wv, int nwv, int lane, int sel) {
    const bf16* PRKV = P.PRKV; bf16* L2O = P.L2O; bf16* SR = P.SR; bf16* SKT = P.SKT; bf16* SWR = P.SWR; bf16* SREM = P.SREM; bf16* SV = P.SV; float* BS = P.BS;
    const float* mu = P.mu; const float* pw0 = P.pw0; const float* pa0 = P.pa0; const float* pkk = P.pkk; const float* pka = P.pka; const float* prk = P.prk;
    { const int q4 = wv & 3, c = 256 * q4 + 4 * lane, head = 4 * q4 + (lane >> 4);
          const f32x4 mur = *(const f32x4*)(mu + c), muk = *(const f32x4*)(mu + DR + c), muv = *(const f32x4*)(mu + 2 * DR + c);
          const f32x4 w0 = *(const f32x4*)(pw0 + c), a0 = *(const f32x4*)(pa0 + c), kkc = *(const f32x4*)(pkk + c), kac = *(const f32x4*)(pka + c), rkc = *(const f32x4*)(prk + c);
          const int per = (sel == 0) ? SEQ / 16 : (sel == 1) ? 3 * SEQ / 16 : SEQ / 4, goff = (sel == 1) ? SEQ / 16 : 0;
          for (int qi = wv >> 2; qi < BATCH * per; qi += nwv >> 2) { const int tg = (qi / per) * (SEQ / 4) + goff + (qi % per);
              const int t0 = 4 * tg; const bool first = (t0 & (SEQ - 1)) == 0;
              const bf16* pc = PRKV + (size_t)t0 * 3072 + c; const u32x2 z2 = {0u, 0u};
              u32x2 rr[5], rk[5], rv[5], lxw[4], lxa[4];
              if (!first) { rr[0] = *(const u32x2*)(pc - 3072); rk[0] = *(const u32x2*)(pc - 3072 + DR); rv[0] = *(const u32x2*)(pc - 3072 + 2 * DR); } else { rr[0] = z2; rk[0] = z2; rv[0] = z2; }
#pragma unroll
              for (int i = 0; i < 4; ++i) { rr[i + 1] = *(const u32x2*)(pc + (size_t)i * 3072); rk[i + 1] = *(const u32x2*)(pc + (size_t)i * 3072 + DR); rv[i + 1] = *(const u32x2*)(pc + (size_t)i * 3072 + 2 * DR);
                  lxw[i] = *(const u32x2*)(L2O + (size_t)(t0 + i) * 3072 + c); lxa[i] = *(const u32x2*)(L2O + (size_t)(t0 + i) * 3072 + DR + c); }
#pragma unroll
              for (int i = 0; i < 4; ++i) {
                  const f32x4 pr = bf4(rr[i + 1]), pk = bf4(rk[i + 1]), pv = bf4(rv[i + 1]);
                  const f32x4 r = pr + (bf4(rr[i]) - pr) * mur, k = pk + (bf4(rk[i]) - pk) * muk, v = pv + (bf4(rv[i]) - pv) * muv;
                  const f32x4 xw = bf4(lxw[i]), xa = bf4(lxa[i]);
                  f32x4 a, d1;
#pragma unroll
                  for (int j = 0; j < 4; ++j) { a[j] = sigmoidf_(a0[j] + xa[j]); d1[j] = 1.0f - fexp2(-0.6065306597126334f * LOG2E * sigmoidf_(w0[j] + xw[j])); }
                  typedef _Float16 h4 __attribute__((ext_vector_type(4)));
                  const h4 dh = {(_Float16)d1[0], (_Float16)d1[1], (_Float16)d1[2], (_Float16)d1[3]};
                  f32x4 kk = k * kkc; const float ss = allsum16((kk[0] * kk[0] + kk[1] * kk[1]) + (kk[2] * kk[2] + kk[3] * kk[3])); kk = kk * __builtin_amdgcn_rsqf(ss + 1e-12f);
                  const f32x4 kt = k * ((a - 1.0f) * kac + 1.0f), pcv = r * kt * rkc;
                  const float bs = allsum16((pcv[0] + pcv[1]) + (pcv[2] + pcv[3]));
                  const size_t off = (size_t)(t0 + i) * DR + c;
                  *(u32x2*)(SR + off) = pk4(r); *(u32x2*)(SKT + off) = pk4(kt); *(u32x2*)(SWR + off) = pk4(kk * a); *(u32x2*)(SREM + off) = pk4(-kk); *(u32x2*)(SV + off) = pk4(v);
                  *(u32x2*)(L2O + (size_t)(t0 + i) * 3072 + c) = __builtin_bit_cast(u32x2, dh);
                  if ((lane & 15) == 0) BS[(size_t)(t0 + i) * 16 + head] = bs; } } }
}

constexpr int SB_KP = 72, SB_VP = 68;
__device__ __forceinline__ u32x4 sb_knorm(u32x4 raw, const f32x4& g0, const f32x4& g1) {
    const f32x4 a = bf4((u32x2){raw.x, raw.y}), b = bf4((u32x2){raw.z, raw.w});
    float ss = ((a[0] * a[0] + a[1] * a[1]) + (a[2] * a[2] + a[3] * a[3])) + ((b[0] * b[0] + b[1] * b[1]) + (b[2] * b[2] + b[3] * b[3]));
    ss += dppf<0xB1>(ss); ss += dppf<0x4E>(ss); ss += dppf<0x141>(ss);
    const float rs = __builtin_amdgcn_rsqf(ss * (1.0f / 64.0f) + 1e-6f);
    const f32x4 x = a * rs * g0, y = b * rs * g1; const u32x2 p = pk4(x), q = pk4(y);
    return (u32x4){p.x, p.y, q.x, q.y};
}
__device__ __forceinline__ void sb_attn_unit(LAS unsigned char* lds, const bf16* PSB, bf16* YC, const float* gq, const float* gk, int b, int h, int qb) {
    const int tid = threadIdx.x, lane = tid & 63, r32 = lane & 31, hi = lane >> 5; const int wid = __builtin_amdgcn_readfirstlane(tid >> 6);
    LAS bf16* Ks = (LAS bf16*)lds; LAS bf16* Vt = (LAS bf16*)(lds + 64 * SB_KP * 2);
    const int q0 = qb * 256; const size_t rowbase = (size_t)b * SEQ;
    const bf16* Qw = PSB + (rowbase + q0 + wid * 32 + r32) * 3072 + h * 64;
    bf16x8 qr[4];
    { u32x4 qraw[4]; float ss = 0.f;
#pragma unroll
      for (int d0 = 0; d0 < 4; ++d0) { qraw[d0] = *(const u32x4*)(Qw + d0 * 16 + hi * 8); const f32x4 a = bf4((u32x2){qraw[d0].x, qraw[d0].y}), c = bf4((u32x2){qraw[d0].z, qraw[d0].w});
          ss += ((a[0] * a[0] + a[1] * a[1]) + (a[2] * a[2] + a[3] * a[3])) + ((c[0] * c[0] + c[1] * c[1]) + (c[2] * c[2] + c[3] * c[3])); }
      ss += __shfl_xor(ss, 32);
      const float rs = __builtin_amdgcn_rsqf(ss * (1.0f / 64.0f) + 1e-6f) * (0.125f * LOG2E);
#pragma unroll
      for (int d0 = 0; d0 < 4; ++d0) { const f32x4 g0 = *(const f32x4*)(gq + d0 * 16 + hi * 8), g1 = *(const f32x4*)(gq + d0 * 16 + hi * 8 + 4);
          const f32x4 a = bf4((u32x2){qraw[d0].x, qraw[d0].y}) * rs * g0, c = bf4((u32x2){qraw[d0].z, qraw[d0].w}) * rs * g1; const u32x2 p = pk4(a), q = pk4(c);
          qr[d0] = __builtin_bit_cast(bf16x8, (u32x4){p.x, p.y, q.x, q.y}); } }
    half8 L0, L1, ones;
#pragma unroll
    for (int j = 0; j < 8; ++j) { const int kv = 4 * hi + (j & 3) + 8 * (j >> 2); L0[j] = (kv > r32) ? (_Float16)1.0f : (_Float16)0.0f; L1[j] = (kv + 16 > r32) ? (_Float16)1.0f : (_Float16)0.0f; ones[j] = (_Float16)1.0f; }
    f32x16 o[2]; o[0] = f32x16{}; o[1] = f32x16{};
    float R = 0.f; bool done = false;
    const int ldrow = tid >> 3, ch = tid & 7;
    const f32x4 gk0 = *(const f32x4*)(gk + 8 * ch), gk1 = *(const f32x4*)(gk + 8 * ch + 4);
    const bf16* kvsrc = PSB + (rowbase + ldrow) * 3072 + h * 64 + 8 * ch;
    int jt = 4 * qb + 3;
    u32x4 kreg = *(const u32x4*)(kvsrc + (size_t)(64 * jt) * 3072 + 1024), vreg = *(const u32x4*)(kvsrc + (size_t)(64 * jt) * 3072 + 2048);
    const int qabs = q0 + wid * 32 + r32;
    for (; jt >= 0; --jt) {
        *(LAS u32x4*)(Ks + ldrow * SB_KP + 8 * ch) = sb_knorm(kreg, gk0, gk1);
        { const unsigned w[4] = {vreg.x, vreg.y, vreg.z, vreg.w};
#pragma unroll
          for (int j = 0; j < 4; ++j) { Vt[(8 * ch + 2 * j) * SB_VP + ldrow] = (bf16)(w[j] & 0xffffu); Vt[(8 * ch + 2 * j + 1) * SB_VP + ldrow] = (bf16)(w[j] >> 16); } }
        __syncthreads();
        if (jt > 0) { kreg = *(const u32x4*)(kvsrc + (size_t)(64 * (jt - 1)) * 3072 + 1024); vreg = *(const u32x4*)(kvsrc + (size_t)(64 * (jt - 1)) * 3072 + 2048); }
        const bool active = !done && (64 * jt < q0 + 32 * wid + 31);
        if (active) {
            f32x16 p[2];
#pragma unroll
            for (int mb = 0; mb < 2; ++mb) { f32x16 a = f32x16{};
#pragma unroll
                for (int d0 = 0; d0 < 4; ++d0) { const bf16x8 kf = *(const LAS bf16x8*)(Ks + (32 * mb + r32) * SB_KP + 16 * d0 + 8 * hi); a = __builtin_amdgcn_mfma_f32_32x32x16_bf16(kf, qr[d0], a, 0, 0, 0); }
                p[mb] = a; }
            const bool diag = (64 * jt + 63 >= q0 + 32 * wid);
            const int kvb = 64 * jt + 4 * hi;
            float sp[2][16];
#pragma unroll
            for (int mb = 0; mb < 2; ++mb)
#pragma unroll
                for (int r = 0; r < 16; ++r) { const int kv = kvb + (r & 3) + 8 * (r >> 2) + 32 * mb; float s = flog2(1.0f + fexp2(p[mb][r])); if (diag && kv >= qabs) s = 0.f; sp[mb][r] = s; }
            half8 spf[4];
#pragma unroll
            for (int s = 0; s < 4; ++s)
#pragma unroll
                for (int j = 0; j < 8; ++j) spf[s][j] = (_Float16)sp[s >> 1][8 * (s & 1) + j];
            f32x16 T0 = f32x16{}, T1 = f32x16{};
            T0 = __builtin_amdgcn_mfma_f32_32x32x16_f16(L0, spf[0], T0, 0, 0, 0); T0 = __builtin_amdgcn_mfma_f32_32x32x16_f16(L1, spf[1], T0, 0, 0, 0);
            T0 = __builtin_amdgcn_mfma_f32_32x32x16_f16(ones, spf[2], T0, 0, 0, 0); T0 = __builtin_amdgcn_mfma_f32_32x32x16_f16(ones, spf[3], T0, 0, 0, 0);
            T1 = __builtin_amdgcn_mfma_f32_32x32x16_f16(L0, spf[2], T1, 0, 0, 0); T1 = __builtin_amdgcn_mfma_f32_32x32x16_f16(L1, spf[3], T1, 0, 0, 0);
            float tot = T0[0] + sp[0][0];
            tot = __shfl(tot, r32);
            float av[2][16];
#pragma unroll
            for (int r = 0; r < 16; ++r) { const int kv = kvb + (r & 3) + 8 * (r >> 2);
                float a0 = fexp2(p[0][r] - sp[0][r] - T0[r] - R), a1 = fexp2(p[1][r] - sp[1][r] - T1[r] - R);
                if (diag && kv >= qabs) a0 = 0.f; if (diag && kv + 32 >= qabs) a1 = 0.f; av[0][r] = a0; av[1][r] = a1; }
            bf16x8 pa[4];
#pragma unroll
            for (int s = 0; s < 4; ++s) { u32x4 w;
                w.x = pk2(av[s >> 1][8 * (s & 1) + 0], av[s >> 1][8 * (s & 1) + 1]); w.y = pk2(av[s >> 1][8 * (s & 1) + 2], av[s >> 1][8 * (s & 1) + 3]);
                w.z = pk2(av[s >> 1][8 * (s & 1) + 4], av[s >> 1][8 * (s & 1) + 5]); w.w = pk2(av[s >> 1][8 * (s & 1) + 6], av[s >> 1][8 * (s & 1) + 7]);
                pa[s] = __builtin_bit_cast(bf16x8, w); }
#pragma unroll
            for (int nb = 0; nb < 2; ++nb)
#pragma unroll
                for (int s = 0; s < 4; ++s) { const LAS bf16* vp = Vt + (r32 + 32 * nb) * SB_VP + 16 * s + 4 * hi;
                    const u32x2 lo = *(const LAS u32x2*)vp, hi2 = *(const LAS u32x2*)(vp + 8);
                    const u32x4 vv = {lo.x, lo.y, hi2.x, hi2.y};
                    o[nb] = __builtin_amdgcn_mfma_f32_32x32x16_bf16(pa[s], __builtin_bit_cast(bf16x8, vv), o[nb], 0, 0, 0); }
            R += tot;
            if (__all(R > 151.0f)) done = true;
        }
        if (__syncthreads_and(done ? 1 : 0)) break;
    }
    bf16* Ow = YC + (rowbase + q0 + wid * 32) * 2048 + 1024 + h * 64;
#pragma unroll
    for (int r = 0; r < 16; ++r) { const int q = (r & 3) + 8 * (r >> 2) + 4 * hi;
#pragma unroll
        for (int nb = 0; nb < 2; ++nb) Ow[(size_t)q * 2048 + r32 + 32 * nb] = (bf16)f2bf(o[nb][r]); }
}

constexpr int SC_TC = 16, SC_REC = 352;
constexpr int SC_INB = SC_TC * SC_REC;
constexpr int SC_YB = SC_TC * 512;
struct ScanRegs { u32x2 r, k, wr, m, d, v; };
struct ScanPtrs { const bf16* SR; const bf16* SKT; const bf16* SWR; const bf16* SREM; const bf16* SV; const bf16* L2O; };
__device__ __forceinline__ void scan_item(LAS unsigned char* lds, const ScanPtrs& P, bf16* YC, int item, unsigned* half_cnt, unsigned half_expect) {
    const int tid = threadIdx.x, lane = tid & 63; const int wid = __builtin_amdgcn_readfirstlane(tid >> 6);
    const int bh = item >> 1, half = item & 1, b = bh >> 4, h = bh & 15;
    LAS float* inb = (LAS float*)lds;
    LAS float* ypb = inb + 2 * SC_INB;
    const size_t tok0 = (size_t)b * SEQ;
    constexpr int NCH = SEQ / SC_TC;
    if (wid >= 4) {
        const int ltid = tid - 256, tk = ltid >> 4, cgp = ltid & 15;
        const bool isv = (cgp >> 3) == half;
        const size_t offA = (tok0 + tk) * DR + h * 64 + 4 * cgp;
        const bf16* lbase = P.L2O + (tok0 + tk) * 3072 + h * 64 + 4 * cgp;
        bf16* yout0 = YC + (tok0 + (ltid >> 5)) * 2048 + h * 64 + 32 * half + (ltid & 31);
        const int yrot = ((ltid & 31) >> 2) & 3;
        ScanRegs q0, q1;
#define SC_LOAD(Q, c) do { const size_t o_ = offA + (size_t)(c) * SC_TC * DR; (Q).r = *(const u32x2*)(P.SR + o_); (Q).k = *(const u32x2*)(P.SKT + o_); (Q).wr = *(const u32x2*)(P.SWR + o_); \
        (Q).m = *(const u32x2*)(P.SREM + o_); (Q).d = *(const u32x2*)(lbase + (size_t)(c) * SC_TC * 3072); if (isv) (Q).v = *(const u32x2*)(P.SV + o_); } while (0)
#define SC_STORE(Q, bi) do { LAS float* rec = inb + (bi) * SC_INB + tk * SC_REC + 4 * cgp; typedef _Float16 h4_ __attribute__((ext_vector_type(4))); const h4_ dh_ = __builtin_bit_cast(h4_, (Q).d); \
        *(LAS f32x4*)(rec) = (f32x4){1.0f - (float)dh_[0], 1.0f - (float)dh_[1], 1.0f - (float)dh_[2], 1.0f - (float)dh_[3]}; \
        *(LAS f32x4*)(rec + 64) = bf4((Q).m); *(LAS f32x4*)(rec + 128) = bf4((Q).wr); *(LAS f32x4*)(rec + 192) = bf4((Q).k); *(LAS f32x4*)(rec + 256) = bf4((Q).r); \
        if (isv) *(LAS f32x4*)(inb + (bi) * SC_INB + tk * SC_REC + 320 + 4 * (cgp & 7)) = bf4((Q).v); } while (0)
#define SC_YRED(bi, c) do { _Pragma("unroll") for (int hh = 0; hh < 2; ++hh) { const LAS f32x4* yp_ = (const LAS f32x4*)(ypb + (bi) * SC_YB + (ltid + 256 * hh) * 16); \
        const f32x4 a_ = yp_[yrot], b_ = yp_[(yrot + 1) & 3], c_ = yp_[(yrot + 2) & 3], d_ = yp_[(yrot + 3) & 3]; const f32x4 s_ = (a_ + b_) + (c_ + d_); \
        yout0[((size_t)(c) * SC_TC + 8 * hh) * 2048] = (bf16)f2bf((s_[0] + s_[1]) + (s_[2] + s_[3])); } } while (0)
        SC_LOAD(q0, 0); SC_LOAD(q1, 1); SC_STORE(q0, 0); SC_LOAD(q0, 2);
        __syncthreads();
        for (int c = 0; c < NCH; c += 2) {
            if (c == NCH / 4 - 8) {
                unsigned sp_ = 0u; while (xb_ld(half_cnt) < half_expect) { __builtin_amdgcn_s_sleep(8); if (++sp_ > (1u << 20)) break; }
                __builtin_amdgcn_fence(__ATOMIC_ACQUIRE, "agent"); asm volatile("s_waitcnt vmcnt(0)" ::: "memory"); }
            SC_STORE(q1, 1); if (c + 3 < NCH) SC_LOAD(q1, c + 3);
            if (c > 0) SC_YRED(1, c - 1);
            __syncthreads();
            if (c + 2 < NCH) SC_STORE(q0, 0); if (c + 4 < NCH) SC_LOAD(q0, c + 4);
            SC_YRED(0, c);
            __syncthreads();
        }
        SC_YRED(1, NCH - 1);
#undef SC_LOAD
#undef SC_STORE
#undef SC_YRED
    } else {
        const int g = lane & 15, ra = 8 * wid + (lane >> 4);
        f32x2 A01 = {0.f, 0.f}, A23 = {0.f, 0.f}, B01 = {0.f, 0.f}, B23 = {0.f, 0.f};
        __builtin_amdgcn_s_setprio(3);
        __syncthreads();
        for (int c = 0; c < NCH; ++c) {
            const LAS float* Bk = inb + (c & 1) * SC_INB + 4 * g;
            const LAS float* Bv = inb + (c & 1) * SC_INB + 320 + ra;
            LAS float* Y = ypb + (c & 1) * SC_YB + ra * 16 + g;
            f32x4 cw, cm, cwr, ck, cr, nw, nm, nwr, nk, nr; float cva, cvb, nva, nvb;
#define SC_RD(s, W, Mm, WR, Kk, Rr, Va, Vb) do { W = *(const LAS f32x4*)(Bk + (s) * SC_REC); Mm = *(const LAS f32x4*)(Bk + (s) * SC_REC + 64); WR = *(const LAS f32x4*)(Bk + (s) * SC_REC + 128); \
                Kk = *(const LAS f32x4*)(Bk + (s) * SC_REC + 192); Rr = *(const LAS f32x4*)(Bk + (s) * SC_REC + 256); Va = Bv[(s) * SC_REC]; Vb = Bv[(s) * SC_REC + 4]; } while (0)
            SC_RD(0, cw, cm, cwr, ck, cr, cva, cvb);
#pragma unroll
            for (int s = 0; s < SC_TC; ++s) {
                if (s + 1 < SC_TC) SC_RD(s + 1, nw, nm, nwr, nk, nr, nva, nvb);
                __builtin_amdgcn_sched_barrier(0);
                const f32x2 m01 = {cm[0], cm[1]}, m23 = {cm[2], cm[3]}, w01 = {cw[0], cw[1]}, w23 = {cw[2], cw[3]}, wr01 = {cwr[0], cwr[1]}, wr23 = {cwr[2], cwr[3]},
                            k01 = {ck[0], ck[1]}, k23 = {ck[2], ck[3]}, r01 = {cr[0], cr[1]}, r23 = {cr[2], cr[3]};
                f32x2 qa = A01 * m01; qa = __builtin_elementwise_fma(A23, m23, qa);
                f32x2 qb = B01 * m01; qb = __builtin_elementwise_fma(B23, m23, qb);
                float da = qa[0] + qa[1], db = qb[0] + qb[1];
                const f32x2 vka01 = k01 * cva, vka23 = k23 * cva, vkb01 = k01 * cvb, vkb23 = k23 * cvb;
                da += dppf<0xB1>(da);  db += dppf<0xB1>(db);
                da += dppf<0x4E>(da);  db += dppf<0x4E>(db);
                da += dppf<0x141>(da); db += dppf<0x141>(db);
                da += dppf<0x140>(da); db += dppf<0x140>(db);
                const f32x2 sa2 = {da, da}, sb2 = {db, db};
                A01 = __builtin_elementwise_fma(A01, w01, __builtin_elementwise_fma(wr01, sa2, vka01)); A23 = __builtin_elementwise_fma(A23, w23, __builtin_elementwise_fma(wr23, sa2, vka23));
                B01 = __builtin_elementwise_fma(B01, w01, __builtin_elementwise_fma(wr01, sb2, vkb01)); B23 = __builtin_elementwise_fma(B23, w23, __builtin_elementwise_fma(wr23, sb2, vkb23));
                f32x2 ya = A01 * r01; ya = __builtin_elementwise_fma(A23, r23, ya);
                f32x2 yb = B01 * r01; yb = __builtin_elementwise_fma(B23, r23, yb);
                Y[s * 512] = ya[0] + ya[1]; Y[s * 512 + 64] = yb[0] + yb[1];
                __builtin_amdgcn_sched_barrier(0);
                cw = nw; cm = nm; cwr = nwr; ck = nk; cr = nr; cva = nva; cvb = nvb;
            }
#undef SC_RD
            __syncthreads();
        }
        __builtin_amdgcn_s_setprio(0);
    }
}

#define XB_TMO      128
#define XB_XCNT(j)  (256  + 64 * (j))
#define XB_XSUB(j)  (1280 + 64 * (j))
#define XB_XGEN(j)  (2304 + 64 * (j))
#define XB_TOP      3328
#define XB_TOPGEN   3392
#define XCD_BAR_WORDS 3456
#define XB_SPIN_CAP (1u << 18)
__device__ __forceinline__ unsigned xb_xcc_id() { return (unsigned)__builtin_amdgcn_s_getreg((3 << 11) | 20) & 0xFu; }
#define XB_SPIN(cond, bar) do { unsigned _sp = 0; while (cond) { __builtin_amdgcn_s_sleep(1); \
    if ((++_sp & 255u) == 0u) { if (xb_ld(&(bar)[XB_TMO])) break; if (_sp > XB_SPIN_CAP) { atomicAdd(&(bar)[XB_TMO], 1u); break; } } } } while (0)
struct XcdBarrier { unsigned* bar; unsigned x; volatile LAS unsigned* st; };
__device__ __forceinline__ XcdBarrier xcd_barrier_post(unsigned* bar, volatile LAS unsigned* st) {
    XcdBarrier b; b.bar = bar; b.x = xb_xcc_id(); b.st = st;
    if (threadIdx.x == 0) (void)xb_add(&bar[XB_XCNT(b.x)], 1u);
    return b;
}
__device__ __forceinline__ void xcd_barrier_complete(unsigned* bar, unsigned x, unsigned& nloc, unsigned& nx) {
    const unsigned G = gridDim.x * gridDim.y * gridDim.z;
    unsigned sum, cnt, mine, sp = 0u;
    for (;;) {
        sum = 0u; cnt = 0u; mine = 0u;
#pragma unroll
        for (unsigned j = 0; j < 16; ++j) { const unsigned c = xb_ld(&bar[XB_XCNT(j)]); sum += c; cnt += (c > 0u) ? 1u : 0u; mine = (j == x) ? c : mine; }
        if (sum == G) break;
        __builtin_amdgcn_s_sleep(1);
        if ((++sp & 255u) == 0u) { if (xb_ld(&bar[XB_TMO])) break; if (sp > XB_SPIN_CAP) { atomicAdd(&bar[XB_TMO], 1u); break; } }
    }
    nloc = mine > 0u ? mine : 1u; nx = cnt > 0u ? cnt : 1u;
}
__device__ __forceinline__ void xcd_barrier(const XcdBarrier& b) {
    asm volatile("s_waitcnt vmcnt(0)" ::: "memory");
    __syncthreads();
    if (threadIdx.x == 0) {
        unsigned* bar = b.bar;
        __builtin_amdgcn_s_waitcnt(0);
        unsigned nloc = b.st[0], nx = b.st[1];
        if (nloc == 0u) { xcd_barrier_complete(bar, b.x, nloc, nx); b.st[0] = nloc; b.st[1] = nx; }
        const unsigned old = xb_add(&bar[XB_XSUB(b.x)], 1u);
        const unsigned gen = old / nloc;
        if (old + 1u == (gen + 1u) * nloc) {
            __builtin_amdgcn_fence(__ATOMIC_RELEASE, "agent");
            asm volatile("s_waitcnt vmcnt(0)" ::: "memory");
            const unsigned og = xb_add(&bar[XB_TOP], 1u);
            const unsigned tg = og / nx;
            if (og + 1u == (tg + 1u) * nx) xb_add(&bar[XB_TOPGEN], 1u);
            else XB_SPIN(xb_ld(&bar[XB_TOPGEN]) == tg, bar);
            __builtin_amdgcn_fence(__ATOMIC_ACQUIRE, "agent");
            xb_add(&bar[XB_XGEN(b.x)], 1u);
            asm volatile("s_waitcnt vmcnt(0)" ::: "memory");
        } else {
            XB_SPIN(xb_ld(&bar[XB_XGEN(b.x)]) == gen, bar);
            __builtin_amdgcn_fence(__ATOMIC_ACQUIRE, "agent");
            asm volatile("s_waitcnt vmcnt(0)" ::: "memory");
        }
    }
    __syncthreads();
}

struct Args { const float* in[29]; float* out; unsigned char* ws; int ph_lo, ph_hi; };
constexpr int N_PHASES = 12;

__global__ void __launch_bounds__(512, 2) mk_fwd(Args args) {
    extern __shared__ __attribute__((aligned(16))) unsigned char lds_raw[];
    LAS unsigned char* lds = (LAS unsigned char*)lds_raw;
    cg::grid_group grid = cg::this_grid();
    const int wave = __builtin_amdgcn_readfirstlane(threadIdx.x >> 6);
    const int G = gridDim.x, NGW = G * 8, NGT = G * 512;
    unsigned char* ws = args.ws;
    const float* x = args.in[0]; float* out = args.out;
    float* mod = (float*)(ws + WS_CTL);
    bf16* W1T = (bf16*)(ws + WS_W1T); bf16* WOT = (bf16*)(ws + WS_WOT); bf16* WGUT = (bf16*)(ws + WS_WGUT); bf16* WDT = (bf16*)(ws + WS_WDT); bf16* W2T = (bf16*)(ws + WS_W2T);
    bf16* Hb = (bf16*)(ws + WS_H); bf16* PRKV = (bf16*)(ws + WS_PRKV); bf16* PSB = (bf16*)(ws + WS_PSB); bf16* PLORA = (bf16*)(ws + WS_PLORA);
    bf16* HID = (bf16*)(ws + WS_HID); bf16* L2O = (bf16*)(ws + WS_L2O); bf16* ACT = (bf16*)(ws + WS_ACT); bf16* YC = (bf16*)(ws + WS_YCAT);
    float* rowss = (float*)(ws + 256 * 1024); float* c2v = (float*)(ws + 320 * 1024);
    unsigned* hcnt = (unsigned*)(ws + WS_BAR) + 8192;
    bf16* H2 = (bf16*)(ws + WS_L2O);
    float* BS = (float*)(ws + WS_BS);
    bf16* SR = (bf16*)out; bf16* SKT = SR + SCAN_ARR; bf16* SWR = SKT + SCAN_ARR; bf16* SREM = SWR + SCAN_ARR;
    bf16* SV = (bf16*)(ws + WS_SV);
    const int lo = args.ph_lo, hi = args.ph_hi;
#define IN(k) (lo <= (k) && (k) < hi)
    volatile LAS unsigned* MISC = (volatile LAS unsigned*)(lds + 131072 + 64);
    if (threadIdx.x < 16) MISC[threadIdx.x] = 0u;
    __syncthreads();
    XcdBarrier xbar = xcd_barrier_post((unsigned*)(ws + WS_BAR), MISC);
    if (args.ph_lo < 0) grid.sync();
#define SEAM(k) do { if ((k) != 9 && IN(k) && IN((k) + 1)) xcd_barrier(xbar); } while (0)

    if (IN(0)) { PHASE_IDS();
        LAS float* scr = (LAS float*)(lds + wave * 16384);
        const float* w_in = args.in[6]; const float* mu_w = args.in[8]; const float* mu_a = args.in[9]; const float* mu_g = args.in[10];
        const float* w1 = args.in[12]; const float* a1 = args.in[15]; const float* g1 = args.in[17];
        const float* w_out = args.in[26]; const float* w_gu = args.in[27]; const float* w_dn = args.in[28];
        constexpr int I_IN = 32 * 192, I_L = 2 * (64 + 64 + 160);
        constexpr int NITEMS = I_IN + I_L;
        for (int rep = 0; rep < (PROBE == 3 ? 2 : 1); ++rep)
        for (int it = gw; it < NITEMS; it += NGW) {
            int r = it;
            if (r < I_IN) { p0_transpose_item(w_in, 6144, W1T, DM, 32 * (r % 192), scr, r / 192, r % 192, lane, nullptr, 0); continue; } r -= I_IN;
            { const int part = r / NLORA; int q = r % NLORA;
                const int rb = 6144 + part * NLORA;
                if (q < 64) { p0_transpose_item(w1, 64, W1T, DM, rb + 32 * (q % 2), scr, q / 2, q % 2, lane, mu_w, 1 + part); continue; } q -= 64;
                if (q < 64) { p0_transpose_item(a1, 64, W1T, DM, rb + 64 + 32 * (q % 2), scr, q / 2, q % 2, lane, mu_a, 1 + part); continue; } q -= 64;
                p0_transpose_item(g1, 160, W1T, DM, rb + 128 + 32 * (q % 5), scr, q / 5, q % 5, lane, mu_g, 1 + part); }
        }
        if (G < 256) late_weight_copies(w_out, w_gu, w_dn, WOT, WGUT, WDT, scr, lane, gw, NGW);
        for (int i = gtid; i < 192 * DM / 8; i += NGT) ((u32x4*)(W1T + (size_t)6720 * DM))[i] = (u32x4){0u, 0u, 0u, 0u};
        { const float* w2 = args.in[13]; const float* a2 = args.in[16]; const float* g2 = args.in[18];
          for (int i0 = gtid; i0 < 3072 * KH; i0 += 9 * NGT) { float v[9];
#pragma unroll
              for (int e = 0; e < 9; ++e) { const int i = i0 + e * NGT; v[e] = 0.f;
                  if (i < 3072 * KH) { const int row = i / KH, kk = i % KH, seg = row >> 10, c = row & 1023;
                      if (seg == 0) { if (kk < 64) v[e] = w2[kk * DR + c]; } else if (seg == 1) { if (kk >= 64 && kk < 128) v[e] = a2[(kk - 64) * DR + c]; } else { if (kk >= 128 && kk < 288) v[e] = g2[(kk - 128) * DR + c]; } } }
#pragma unroll
              for (int e = 0; e < 9; ++e) { const int i = i0 + e * NGT; if (i < 3072 * KH) W2T[i] = (bf16)f2bf(v[e]); } } }
        { const float* cvec = args.in[1]; const float* w_ada = args.in[2]; const float* b_ada = args.in[3];
          for (int it = gtid; it < 32 * 3072; it += NGT) { const int kc = it / 3072, n4 = it % 3072;
              f32x4 a0 = {0.f, 0.f, 0.f, 0.f}, a1v = a0, a2v = a0, a3v = a0;
              for (int k0 = 64 * kc; k0 < 64 * kc + 64; k0 += 16) { f32x4 wv[16];
#pragma unroll
                  for (int u = 0; u < 16; ++u) wv[u] = __builtin_nontemporal_load((const f32x4*)(w_ada + (size_t)(k0 + u) * NMOD + 4 * n4));
#pragma unroll
                  for (int u = 0; u < 16; ++u) { const int k = k0 + u; const float c0 = cvec[k], c1 = cvec[DM + k], c2 = cvec[2 * DM + k], c3 = cvec[3 * DM + k];
                      a0 += wv[u] * (c0 * sigmoidf_(c0)); a1v += wv[u] * (c1 * sigmoidf_(c1)); a2v += wv[u] * (c2 * sigmoidf_(c2)); a3v += wv[u] * (c3 * sigmoidf_(c3)); } }
              if (kc == 0) { const f32x4 bv = *(const f32x4*)(b_ada + 4 * n4); a0 += bv; a1v += bv; a2v += bv; a3v += bv; }
#pragma unroll
              for (int j = 0; j < 4; ++j) { atomicAdd(mod + 4 * n4 + j, a0[j]); atomicAdd(mod + NMOD + 4 * n4 + j, a1v[j]); atomicAdd(mod + 2 * NMOD + 4 * n4 + j, a2v[j]); atomicAdd(mod + 3 * NMOD + 4 * n4 + j, a3v[j]); } } }
    }
    SEAM(0);
    if (IN(1)) { PHASE_IDS(); const float* g1n = args.in[4];
        if (G < 256) sh2_gemv(mod, args.in[27], c2v, gtid, NGT);
        for (int m = 2 * gw; m < MTOK; m += 2 * NGW) { const float* mb = mod + (size_t)(m >> 12) * NMOD; modnorm_row2(x + (size_t)m * DM, Hb + (size_t)m * DM, g1n, mb + DM, mb, lane); } }
    SEAM(1);
    if (IN(2)) { pg8::Gemm g{Hb, W1T, MTOK, NP1, DM}; pg8::StaticOrder S; S.init(MTOK, NP1, G, (int)blockIdx.x);
        pg8::EpiStore E{PRKV, PSB, PLORA, 12, 24, 3072, 3072, 768};
        pg8::gemm_phase<pg8::EpiStore, pg8::StaticOrder, true, true>(lds, g, S, E); }
    SEAM(2);
    if (IN(3)) { PHASE_IDS();
        for (int it0 = gtid; it0 < MTOK * 48; it0 += 2 * NGT) {
            u32x4 ua[2], ub[2]; int tt[2], jj[2]; bool ok[2];
#pragma unroll
            for (int e = 0; e < 2; ++e) { const int it = it0 + e * NGT; ok[e] = it < MTOK * 48; tt[e] = it / 48; jj[e] = it % 48; ua[e] = (u32x4){0u, 0u, 0u, 0u}; ub[e] = ua[e];
                if (ok[e] && jj[e] < 36) { ua[e] = *(const u32x4*)(PLORA + (size_t)tt[e] * 768 + 8 * jj[e]);
                    if ((tt[e] & (SEQ - 1)) != 0) ub[e] = *(const u32x4*)(PLORA + (size_t)(tt[e] - 1) * 768 + NLORA + 8 * jj[e]); } }
#pragma unroll
            for (int e = 0; e < 2; ++e) { if (!ok[e]) continue; const int j = jj[e]; u32x4 o = {0u, 0u, 0u, 0u};
                if (j < 36) { const unsigned a4[4] = {ua[e].x, ua[e].y, ua[e].z, ua[e].w}, b4[4] = {ub[e].x, ub[e].y, ub[e].z, ub[e].w}; unsigned r4[4];
#pragma unroll
                    for (int q = 0; q < 4; ++q) { float v0 = bflo(a4[q]) + bflo(b4[q]), v1 = bfhi(a4[q]) + bfhi(b4[q]);
                        if (j < 8) { v0 = 1.0f - 2.0f * frcp(1.0f + fexp2(2.0f * LOG2E * v0)); v1 = 1.0f - 2.0f * frcp(1.0f + fexp2(2.0f * LOG2E * v1)); }
                        else if (j >= 16) { v0 = sigmoidf_(v0); v1 = sigmoidf_(v1); }
                        r4[q] = pk2(v0, v1); }
                    o = (u32x4){r4[0], r4[1], r4[2], r4[3]}; }
                *(u32x4*)(HID + (size_t)tt[e] * KH + 8 * j) = o; } } }
    SEAM(3);
    if (IN(4)) {
        { pg8::Gemm g{HID, W2T, MTOK, 2048, 256, KH, KH}; pg8::StaticOrder S; S.init(MTOK, 2048, G, (int)blockIdx.x);
          pg8::EpiStore E{L2O, L2O, L2O, 1000, 1000, 3072, 3072, 3072};
          pg8::gemm_phase<pg8::EpiStore, pg8::StaticOrder, true, true>(lds, g, S, E); }
        { pg8::Gemm g{HID + 128, W2T + (size_t)2048 * KH + 128, MTOK, 1024, 256, KH, KH}; pg8::StaticOrder S; S.init(MTOK, 1024, G, (int)blockIdx.x);
          pg8::EpiStore E{L2O + 2048, L2O + 2048, L2O + 2048, 1000, 1000, 3072, 3072, 3072};
          pg8::gemm_phase<pg8::EpiStore, pg8::StaticOrder, true, true>(lds, g, S, E); } }
    SEAM(4);
    if (IN(5)) { PHASE_IDS();
        { const PrepPtrs PP{PRKV, L2O, SR, SKT, SWR, SREM, SV, BS, args.in[7], args.in[11], args.in[14], args.in[19], args.in[20], args.in[21]};
          rwkv_prep(PP, gw, NGW, lane, (G >= 256) ? 0 : 2); }
    }
    SEAM(5);
    if (IN(6)) { PHASE_IDS();
        { ScanPtrs SP{SR, SKT, SWR, SREM, SV, L2O};
          const bool split = (G >= 256);
          const int sstride = split ? 128 : G;
          if (!split || blockIdx.x < 128)
              for (int rep = 0; rep < (PROBE == 1 ? 2 : 1); ++rep) for (int item = blockIdx.x; item < 128; item += sstride) { scan_item(lds, SP, YC, item, hcnt, split ? (unsigned)(G - 128) : 0u); __syncthreads(); }
          if (!split || blockIdx.x >= 128) { const int ablk = split ? (int)blockIdx.x - 128 : (int)blockIdx.x, astride = split ? G - 128 : G;
              if (split) {
                  const PrepPtrs PP{PRKV, L2O, SR, SKT, SWR, SREM, SV, BS, args.in[7], args.in[11], args.in[14], args.in[19], args.in[20], args.in[21]};
                  rwkv_prep(PP, ablk * 8 + wave, astride * 8, lane, 1);
                  asm volatile("s_waitcnt vmcnt(0)" ::: "memory"); __syncthreads();
                  if (threadIdx.x == 0) { __builtin_amdgcn_fence(__ATOMIC_RELEASE, "agent"); asm volatile("s_waitcnt vmcnt(0)" ::: "memory"); xb_add(hcnt, 1u); }
                  __syncthreads(); }
              for (int rep = 0; rep < (PROBE == 2 ? 2 : 1); ++rep) for (int u = ablk; u < 1024; u += astride) { sb_attn_unit(lds, PSB, YC, args.in[24], args.in[25], u >> 8, (u >> 4) & 15, u & 15); __syncthreads(); }
              if (split) { late_weight_copies(args.in[26], args.in[27], args.in[28], WOT, WGUT, WDT, (LAS float*)(lds + wave * 16384), lane, ablk * 8 + wave, astride * 8);
                  sh2_gemv(mod, args.in[27], c2v, ablk * 512 + tid, astride * 512); } } }
    }
    SEAM(6);
    if (IN(7)) { PHASE_IDS(); const int q4 = gw & 3, c = 256 * q4 + 4 * lane;
        const f32x4 lng = *(const f32x4*)(args.in[22] + c), lnb = *(const f32x4*)(args.in[23] + c);
        const int head = 4 * q4 + (lane >> 4);
        for (int tg = gw >> 2; tg < MTOK / 8; tg += NGW >> 2) {
            u32x2 ly[8], lv[8], lg[8]; float lb[8];
            const int t0 = 8 * tg;
#pragma unroll
            for (int i = 0; i < 8; ++i) { const int t = t0 + i;
                ly[i] = *(const u32x2*)(YC + (size_t)t * 2048 + c); lv[i] = *(const u32x2*)(SV + (size_t)t * DR + c); lg[i] = *(const u32x2*)(L2O + (size_t)t * 3072 + 2 * DR + c); lb[i] = BS[(size_t)t * 16 + head]; }
#pragma unroll
            for (int i = 0; i < 8; ++i) { const int t = t0 + i;
                const f32x4 y = bf4(ly[i]), v = bf4(lv[i]), gg = bf4(lg[i]);
                const float mean = allsum16((y[0] + y[1]) + (y[2] + y[3])) * (1.0f / 64.0f);
                const f32x4 dy = y - mean; const float var = allsum16((dy[0] * dy[0] + dy[1] * dy[1]) + (dy[2] * dy[2] + dy[3] * dy[3])) * (1.0f / 64.0f);
                const f32x4 o = (dy * __builtin_amdgcn_rsqf(var + 64e-5f) * lng + lnb + v * lb[i]) * gg;
                *(u32x2*)(YC + (size_t)t * 2048 + c) = pk4(o); } } }
    SEAM(7);
    if (IN(8)) { pg8::Gemm g{YC, WOT, MTOK, DM, DM}; pg8::StaticOrder S; S.init(MTOK, DM, G, (int)blockIdx.x);
        pg8::EpiResH2 E{x, out, mod, args.in[5], H2, rowss};
        pg8::gemm_phase<pg8::EpiResH2, pg8::StaticOrder, true, true>(lds, g, S, E); }
    SEAM(8);
    SEAM(9);
    if (IN(10)) { pg8::Gemm g{H2, WGUT, MTOK, 2 * DFF, DM}; pg8::StaticOrder S; S.init(MTOK, 2 * DFF, G, (int)blockIdx.x);
        pg8::EpiSwiGLU E{ACT, rowss, c2v};
        for (int rep = 0; rep < (PROBE == 4 ? 2 : 1); ++rep) pg8::gemm_phase<pg8::EpiSwiGLU, pg8::StaticOrder, true, true>(lds, g, S, E); }
    SEAM(10);
    if (IN(11)) { pg8::Gemm g{ACT, WDT, MTOK, DM, DFF}; pg8::StaticOrder S; S.init(MTOK, DM, G, (int)blockIdx.x);
        pg8::EpiRes E{out, out, mod + 5 * DM};
        pg8::gemm_phase<pg8::EpiRes, pg8::StaticOrder, true, true>(lds, g, S, E); }
#undef IN
#undef SEAM
}

#ifndef MK_N_LAUNCHES
#define MK_N_LAUNCHES 1
#endif
extern "C" void kernel_launch(void* const* d_in, const int* in_sizes, int n_in, void* d_out, int out_size, void* d_ws, size_t ws_size, hipStream_t stream) {
    static int grid = 0;
    if (grid == 0) {
        if (n_in != 29 || in_sizes[0] != MTOK * DM || out_size != MTOK * DM || ws_size < WS_END) { fprintf(stderr, "kernel_launch: unexpected shapes / workspace (n_in %d, ws %zu, need %zu)\n", n_in, ws_size, (size_t)WS_END); grid = -1; return; }
        int dev = 0, cus = 0, per_cu = 0;
        if (hipGetDevice(&dev) != hipSuccess || hipDeviceGetAttribute(&cus, hipDeviceAttributeMultiprocessorCount, dev) != hipSuccess) { grid = -1; return; }
        if (hipFuncSetAttribute((const void*)mk_fwd, hipFuncAttributeMaxDynamicSharedMemorySize, LDS_BYTES) != hipSuccess) { fprintf(stderr, "kernel_launch: hipFuncSetAttribute failed\n"); grid = -1; return; }
        if (hipOccupancyMaxActiveBlocksPerMultiprocessor(&per_cu, (const void*)mk_fwd, 512, LDS_BYTES) != hipSuccess || per_cu < 1) { fprintf(stderr, "kernel_launch: occupancy query says %d blocks per CU\n", per_cu); per_cu = 1; }
        (void)hipGetLastError();
        grid = cus;
    }
    if (grid < 0) return;
    (void)hipMemsetAsync((char*)d_ws + WS_CTL, 0, CTL_ZERO_BYTES, stream);
    Args a{};
    for (int i = 0; i < 29; ++i) a.in[i] = (const float*)d_in[i];
    a.out = (float*)d_out; a.ws = (unsigned char*)d_ws;
#if MK_N_LAUNCHES == 1
    a.ph_lo = 0; a.ph_hi = N_PHASES;
    void* kargs[] = {&a};
    hipError_t e = hipLaunchCooperativeKernel((const void*)mk_fwd, dim3(grid), dim3(512), kargs, LDS_BYTES, stream);
    if (e != hipSuccess) fprintf(stderr, "cooperative launch failed: %s (grid %d)\n", hipGetErrorString(e), grid);
#else
    for (int p = 0; p < N_PHASES; ++p) { a.ph_lo = p; a.ph_hi = p + 1; hipLaunchKernelGGL(mk_fwd, dim3(grid), dim3(512), LDS_BYTES, stream, a); }
#endif
}
```

```cpp
#include <hip/hip_runtime.h>
#include <hip/hip_cooperative_groups.h>
#include <cstdio>
#include <cstdint>
namespace cg = cooperative_groups;

#define LAS __attribute__((address_space(3)))
typedef unsigned short bf16;
typedef short bf16x8 __attribute__((ext_vector_type(8)));
typedef _Float16 half8 __attribute__((ext_vector_type(8)));
typedef float f32x4 __attribute__((ext_vector_type(4)));
typedef float f32x2 __attribute__((ext_vector_type(2)));
typedef float f32x16 __attribute__((ext_vector_type(16)));
typedef unsigned u32x4 __attribute__((ext_vector_type(4)));
typedef unsigned u32x2 __attribute__((ext_vector_type(2)));

constexpr int BATCH = 4, SEQ = 4096, DM = 2048, MTOK = BATCH * SEQ, NH = 16, HD = 64, DR = 1024, DFF = 5632;
constexpr int NLORA = 288, NP1 = 6912, KH = 384, NMOD = 6 * DM;
constexpr float LOG2E = 1.4426950408889634f;

constexpr size_t MiB = 1u << 20;
constexpr size_t WS_CTL = 0, CTL_ZERO_BYTES = 1 * MiB, WS_BAR = 512 * 1024;
constexpr size_t WS_W1T = 1 * MiB, WS_WOT = 28 * MiB, WS_WGUT = 36 * MiB, WS_WDT = 80 * MiB, WS_W2T = 102 * MiB;
constexpr size_t WS_H = 105 * MiB, WS_PRKV = 169 * MiB, WS_PSB = 265 * MiB, WS_PLORA = 361 * MiB, WS_HID = 385 * MiB, WS_L2O = 397 * MiB, WS_BS = 493 * MiB, WS_END = 496 * MiB;
constexpr size_t WS_ACT = WS_PRKV, WS_YCAT = WS_H;
constexpr size_t WS_SV = WS_PLORA;
constexpr size_t WS_AB = 494 * MiB;
constexpr size_t SCAN_ARR = (size_t)MTOK * DR;
constexpr int LDS_BYTES = 132096;
#ifndef MK_PROBE
#define MK_PROBE 0
#endif
constexpr int PROBE = MK_PROBE;

__device__ __forceinline__ unsigned f2bf(float f) { unsigned u = __builtin_bit_cast(unsigned, f); return (u + 0x7fffu + ((u >> 16) & 1u)) >> 16; }
__device__ __forceinline__ unsigned pk2(float lo, float hi) { unsigned r; asm volatile("v_cvt_pk_bf16_f32 %0, %1, %2" : "=v"(r) : "v"(lo), "v"(hi)); return r; }
__device__ __forceinline__ float bflo(unsigned u) { return __builtin_bit_cast(float, u << 16); }
__device__ __forceinline__ float bfhi(unsigned u) { return __builtin_bit_cast(float, u & 0xffff0000u); }
__device__ __forceinline__ f32x4 bf4(u32x2 u) { return (f32x4){bflo(u.x), bfhi(u.x), bflo(u.y), bfhi(u.y)}; }
__device__ __forceinline__ u32x2 pk4(f32x4 v) { u32x2 r; r.x = pk2(v[0], v[1]); r.y = pk2(v[2], v[3]); return r; }
__device__ __forceinline__ float fexp2(float x) { return __builtin_amdgcn_exp2f(x); }
__device__ __forceinline__ float flog2(float x) { return __builtin_amdgcn_logf(x); }
__device__ __forceinline__ float frcp(float x) { return __builtin_amdgcn_rcpf(x); }
__device__ __forceinline__ float sigmoidf_(float x) { return frcp(1.0f + fexp2(-x * LOG2E)); }
template <int CTRL> __device__ __forceinline__ float dppf(float x) { return __builtin_bit_cast(float, __builtin_amdgcn_update_dpp(0, __builtin_bit_cast(int, x), CTRL, 0xf, 0xf, true)); }
__device__ __forceinline__ float allsum16(float x) { x += dppf<0xB1>(x); x += dppf<0x4E>(x); x += dppf<0x141>(x); x += dppf<0x140>(x); return x; }
__device__ __forceinline__ float wave_sum(float v) {
#pragma unroll
    for (int o = 1; o < 64; o <<= 1) v += __shfl_xor(v, o);
    return v;
}

__device__ __forceinline__ int tid_opaque() { int t = threadIdx.x; asm volatile("" : "+v"(t)); return t; }
#define PHASE_IDS() const int tid = tid_opaque(), lane = tid & 63; const int gw = blockIdx.x * 8 + wave, gtid = blockIdx.x * 512 + tid; (void)lane; (void)gw; (void)gtid
__device__ __forceinline__ unsigned xb_ld(unsigned* p)              { return __hip_atomic_load(p, __ATOMIC_RELAXED, __HIP_MEMORY_SCOPE_AGENT); }
__device__ __forceinline__ unsigned xb_add(unsigned* p, unsigned v) { return __hip_atomic_fetch_add(p, v, __ATOMIC_RELAXED, __HIP_MEMORY_SCOPE_AGENT); }
namespace pg8 {
typedef unsigned short bf16_t;
constexpr int BM = 256, BK = 64, HALF = 128, HTB = HALF * BK * 2, STAGE_BYTES = 8 * HTB, NXCD = 8, WGM = 4;
__host__ __device__ __forceinline__ int lds_byte(int r, int c) { const int st = (r >> 4) * 2 + (c >> 5), rr = r & 15, cc = c & 31, ob = rr * 64 + cc * 2; return st * 1024 + (ob ^ (((ob >> 9) & 1) << 5)); }
__host__ __device__ __forceinline__ void stage_rc(int b, int& R, int& C) { const int st = b / 1024, sb = b % 1024, swz = sb ^ (((sb >> 9) & 1) << 5); R = (st >> 1) * 16 + swz / 64; C = (st & 1) * 32 + (swz % 64) / 2; }
__host__ __device__ __forceinline__ int perm32(int rho) { const int n = rho >> 4, i = rho & 15; return 8 * (i >> 2) + 4 * n + (i & 3); }
struct Unit { int pm, pn; };
struct Gemm { const bf16_t* A; const bf16_t* Bt; int M, N, K; };
struct StaticOrder {
    int nM, nN, nwg, G, c;
    __host__ __device__ void init(int M, int N, int G_, int c_) { nM = M / BM; nN = N / BM; nwg = nM * nN; G = G_; c = c_; }
    __host__ __device__ bool next(int i, Unit& u) const {
        const long L = (long)i * G + c; if (L >= nwg) return false;
        int wgid = (int)L; { const int q = nwg / NXCD, r = nwg % NXCD, xcd = wgid % NXCD, off = wgid / NXCD; wgid = (xcd < r ? xcd * (q + 1) : r * (q + 1) + (xcd - r) * q) + off; }
        const int nig = WGM * nN, gid = wgid / nig, fm = gid * WGM, gsz = (nM - fm) < WGM ? (nM - fm) : WGM;
        u.pm = fm + ((wgid % nig) % gsz); u.pn = (wgid % nig) / gsz; return true;
    }
    __device__ __forceinline__ void a_ready(const Unit&) const {}
    __device__ __forceinline__ void done(const Unit&) const {}
};

struct EpiStore {
    static constexpr bool PERM = true, AFTER_DRAIN = false;
    bf16_t* O0; bf16_t* O1; bf16_t* O2; int t1, t2; int ld0, ld1, ld2;
    __device__ __forceinline__ void operator()(const f32x4 (&acc)[2][2][4][2], const Unit& u, int wr, int wc, int fr, int fq) const {
        bf16_t* base; int ldc, pn = u.pn;
        if (pn < t1) { base = O0; ldc = ld0; } else if (pn < t2) { base = O1; ldc = ld1; pn -= t1; } else { base = O2; ldc = ld2; pn -= t2; }
        const int row0 = u.pm * BM + wr * 64 + fr, col0 = pn * BM + wc * 32 + 8 * fq;
#pragma unroll
        for (int ai = 0; ai < 2; ++ai)
#pragma unroll
            for (int m = 0; m < 4; ++m) { bf16_t* rowp = base + (size_t)(row0 + ai * HALF + m * 16) * ldc + col0;
#pragma unroll
                for (int bj = 0; bj < 2; ++bj) { const f32x4 v0 = acc[ai][bj][m][0], v1 = acc[ai][bj][m][1];
                    u32x4 w; w.x = pk2(v0[0], v0[1]); w.y = pk2(v0[2], v0[3]); w.z = pk2(v1[0], v1[1]); w.w = pk2(v1[2], v1[3]);
                    *(u32x4*)(rowp + bj * HALF) = w; } }
    }
};
struct EpiRes {
    static constexpr bool PERM = true, AFTER_DRAIN = false;
    const float* base; float* out; const float* gate;
    __device__ __forceinline__ void operator()(const f32x4 (&acc)[2][2][4][2], const Unit& u, int wr, int wc, int fr, int fq) const {
        const int row0 = u.pm * BM + wr * 64 + fr, col0 = u.pn * BM + wc * 32 + 8 * fq, b = u.pm >> 4;
#pragma unroll
        for (int bj = 0; bj < 2; ++bj) { const int c = col0 + bj * HALF;
            const f32x4 gv0 = *(const f32x4*)(gate + (size_t)b * NMOD + c), gv1 = *(const f32x4*)(gate + (size_t)b * NMOD + c + 4);
#pragma unroll
            for (int ai = 0; ai < 2; ++ai) { f32x4 bs[4][2];
#pragma unroll
                for (int m = 0; m < 4; ++m) { const float* p = base + (size_t)(row0 + ai * HALF + m * 16) * DM + c; bs[m][0] = *(const f32x4*)p; bs[m][1] = *(const f32x4*)(p + 4); }
#pragma unroll
                for (int m = 0; m < 4; ++m) { float* o = out + (size_t)(row0 + ai * HALF + m * 16) * DM + c;
                    *(f32x4*)o = bs[m][0] + gv0 * acc[ai][bj][m][0]; *(f32x4*)(o + 4) = bs[m][1] + gv1 * acc[ai][bj][m][1]; }
                asm volatile("" ::: "memory"); } }
    }
};
struct EpiResH2 {
    static constexpr bool PERM = true, AFTER_DRAIN = false;
    const float* base; float* out; const float* mod; const float* g2; bf16_t* h2; float* rowss;
    __device__ __forceinline__ void operator()(const f32x4 (&acc)[2][2][4][2], const Unit& u, int wr, int wc, int fr, int fq) const {
        const int row0 = u.pm * BM + wr * 64 + fr, col0 = u.pn * BM + wc * 32 + 8 * fq; const float* mb = mod + (size_t)(u.pm >> 4) * NMOD;
        float ssacc[2][4];
#pragma unroll
        for (int ai = 0; ai < 2; ++ai)
#pragma unroll
            for (int m = 0; m < 4; ++m) ssacc[ai][m] = 0.f;
#pragma unroll
        for (int bj = 0; bj < 2; ++bj) { const int c = col0 + bj * HALF;
            const f32x4 gv0 = *(const f32x4*)(mb + 2 * DM + c), gv1 = *(const f32x4*)(mb + 2 * DM + c + 4);
            const f32x4 gm0 = *(const f32x4*)(g2 + c) * (*(const f32x4*)(mb + 4 * DM + c) + 1.0f), gm1 = *(const f32x4*)(g2 + c + 4) * (*(const f32x4*)(mb + 4 * DM + c + 4) + 1.0f);
#pragma unroll
            for (int ai = 0; ai < 2; ++ai) { f32x4 bs[4][2];
#pragma unroll
                for (int m = 0; m < 4; ++m) { const float* p = base + (size_t)(row0 + ai * HALF + m * 16) * DM + c; bs[m][0] = *(const f32x4*)p; bs[m][1] = *(const f32x4*)(p + 4); }
#pragma unroll
                for (int m = 0; m < 4; ++m) { const size_t off = (size_t)(row0 + ai * HALF + m * 16) * DM + c;
                    const f32x4 x0 = bs[m][0] + gv0 * acc[ai][bj][m][0], x1 = bs[m][1] + gv1 * acc[ai][bj][m][1];
                    *(f32x4*)(out + off) = x0; *(f32x4*)(out + off + 4) = x1;
                    const u32x2 p0 = pk4(x0 * gm0), p1 = pk4(x1 * gm1); *(u32x4*)(h2 + off) = (u32x4){p0.x, p0.y, p1.x, p1.y};
                    ssacc[ai][m] += ((x0[0] * x0[0] + x0[1] * x0[1]) + (x0[2] * x0[2] + x0[3] * x0[3])) + ((x1[0] * x1[0] + x1[1] * x1[1]) + (x1[2] * x1[2] + x1[3] * x1[3])); }
                asm volatile("" ::: "memory"); } }
#pragma unroll
        for (int ai = 0; ai < 2; ++ai)
#pragma unroll
            for (int m = 0; m < 4; ++m) { float sv = ssacc[ai][m]; sv += __shfl_xor(sv, 16); sv += __shfl_xor(sv, 32);
                if (fq == 0) atomicAdd(rowss + row0 + ai * HALF + m * 16, sv); }
    }
};
struct EpiSwiGLU {
    static constexpr bool PERM = true, AFTER_DRAIN = false;
    bf16_t* O; const float* rowss; const float* c2;
    __device__ __forceinline__ void operator()(const f32x4 (&acc)[2][2][4][2], const Unit& u, int wr, int wc, int fr, int fq) const {
        const int row0 = u.pm * BM + wr * 64 + fr, col0 = u.pn * HALF + wc * 32 + 8 * fq; const float* cb = c2 + (size_t)(u.pm >> 4) * (2 * DFF) + col0;
        const f32x4 cg[2] = {*(const f32x4*)cb, *(const f32x4*)(cb + 4)}, cu[2] = {*(const f32x4*)(cb + DFF), *(const f32x4*)(cb + DFF + 4)};
#pragma unroll
        for (int ai = 0; ai < 2; ++ai)
#pragma unroll
            for (int m = 0; m < 4; ++m) { bf16_t* rowp = O + (size_t)(row0 + ai * HALF + m * 16) * DFF + col0; float v[8];
                const float rs = __builtin_amdgcn_rsqf(rowss[row0 + ai * HALF + m * 16] * (1.0f / DM) + 1e-6f);
#pragma unroll
                for (int n = 0; n < 2; ++n)
#pragma unroll
                    for (int j = 0; j < 4; ++j) { const float g = __builtin_fmaf(rs, acc[ai][0][m][n][j], cg[n][j]), up = __builtin_fmaf(rs, acc[ai][1][m][n][j], cu[n][j]); v[4 * n + j] = g * sigmoidf_(g) * up; }
                u32x4 w; w.x = pk2(v[0], v[1]); w.y = pk2(v[2], v[3]); w.z = pk2(v[4], v[5]); w.w = pk2(v[6], v[7]);
                *(u32x4*)rowp = w; }
    }
};

template <class Epi, class Sched, bool ALIGN_EPI = false, bool SP2 = false>
__device__ __forceinline__ void gemm_phase(LAS unsigned char* lds, const Gemm g, const Sched& S, const Epi& E) {
    const int tid = threadIdx.x, wid = __builtin_amdgcn_readfirstlane(tid >> 6), lane = tid & 63, wr = wid >> 2, wc = wid & 3, fr = lane & 15, fq = lane >> 4;
    const int K = g.K, nt = K / BK;
    unsigned voffA[2], voffB[2];
#pragma unroll
    for (int i = 0; i < 2; ++i) { int R, C; stage_rc(tid * 16 + i * 8192, R, C); const int Rb = Epi::PERM ? ((R & ~31) + perm32(R & 31)) : R;
        voffA[i] = (unsigned)(R * K + C) * 2u; voffB[i] = (unsigned)(Rb * K + C) * 2u; }
    const size_t kstep = (size_t)(BK * 2);
    const size_t hstep = (size_t)HALF * K * 2;
    const size_t tstep = 2 * hstep;
    const unsigned ldsw = (unsigned)wid * 1024u;
    const int aoff = lds_byte(wr * 64 + fr, fq * 8), boff = lds_byte(wc * 32 + fr, fq * 8);
#define PG8_SA(b, h) (((b) * 2 + (h)) * HTB)
#define PG8_SB(b, h) ((4 + (b) * 2 + (h)) * HTB)
#define PG8_STAGE(bufoff, gbase, voff) do { _Pragma("unroll") for (int _i = 0; _i < 2; ++_i) \
        __builtin_amdgcn_global_load_lds((const unsigned*)((const char*)(gbase) + (voff)[_i]), (LAS unsigned*)(lds + (bufoff) + ldsw + _i * 8192), 16, 0, 0); } while (0)
#define PG8_LDA(dst, b, h) do { _Pragma("unroll") for (int m = 0; m < 4; ++m) _Pragma("unroll") for (int k = 0; k < 2; ++k) dst[m][k] = *(const LAS bf16x8*)(lds + PG8_SA(b, h) + aoff + m * 2048 + k * 1024); } while (0)
#define PG8_LDB(dst, b, h) do { _Pragma("unroll") for (int n = 0; n < 2; ++n) _Pragma("unroll") for (int k = 0; k < 2; ++k) dst[n][k] = *(const LAS bf16x8*)(lds + PG8_SB(b, h) + boff + n * 2048 + k * 1024); } while (0)
#define PG8_MMA(ai, bj, At, Bt) do { __builtin_amdgcn_s_setprio(1); _Pragma("unroll") for (int m = 0; m < 4; ++m) _Pragma("unroll") for (int n = 0; n < 2; ++n) _Pragma("unroll") for (int k = 0; k < 2; ++k) \
        acc[ai][bj][m][n] = __builtin_amdgcn_mfma_f32_16x16x32_bf16(Bt[n][k], At[m][k], acc[ai][bj][m][n], 0, 0, 0); __builtin_amdgcn_s_setprio(0); } while (0)
#define PG8_WAIT_V(n) asm volatile("s_waitcnt vmcnt(" #n ")" ::: "memory")
#define PG8_WAIT_L(n) asm volatile("s_waitcnt lgkmcnt(" #n ")" ::: "memory")
#define PG8_BAR __builtin_amdgcn_s_barrier()
#define PG8_SCHED __builtin_amdgcn_sched_barrier(0)
    Unit cur, nxt; int ui = 0;
    if (!S.next(0, cur)) return;
    f32x4 acc[2][2][4][2];
#pragma unroll
    for (int a = 0; a < 2; ++a)
#pragma unroll
        for (int b = 0; b < 2; ++b)
#pragma unroll
            for (int m = 0; m < 4; ++m)
#pragma unroll
                for (int n = 0; n < 2; ++n) acc[a][b][m][n] = (f32x4){0.f, 0.f, 0.f, 0.f};
    bf16x8 At[4][2], B0[2][2], B1[2][2];
    const char* cA = (const char*)g.A + (size_t)cur.pm * tstep; const char* cB = (const char*)g.Bt + (size_t)cur.pn * tstep;
    S.a_ready(cur);
    if constexpr (SP2) {
        PG8_STAGE(PG8_SB(0, 0), cB, voffB); PG8_STAGE(PG8_SB(0, 1), cB + hstep, voffB); PG8_STAGE(PG8_SA(0, 0), cA, voffA); PG8_STAGE(PG8_SA(0, 1), cA + hstep, voffA);
        if (wr == 1) PG8_BAR;
        PG8_WAIT_V(2); PG8_BAR;
        PG8_STAGE(PG8_SB(1, 0), cB + kstep, voffB); PG8_STAGE(PG8_SA(1, 0), cA + kstep, voffA); PG8_STAGE(PG8_SB(1, 1), cB + hstep + kstep, voffB);
        PG8_WAIT_V(6); PG8_BAR;
    } else {
        PG8_STAGE(PG8_SB(0, 0), cB, voffB); PG8_STAGE(PG8_SA(0, 0), cA, voffA); PG8_STAGE(PG8_SB(0, 1), cB + hstep, voffB); PG8_STAGE(PG8_SA(0, 1), cA + hstep, voffA);
        if (wr == 1) PG8_BAR;
        PG8_WAIT_V(4); PG8_BAR;
        PG8_STAGE(PG8_SB(1, 0), cB + kstep, voffB); PG8_STAGE(PG8_SA(1, 0), cA + kstep, voffA); PG8_STAGE(PG8_SB(1, 1), cB + hstep + kstep, voffB);
        PG8_WAIT_V(6); PG8_BAR;
    }
    for (;;) {
        const bool has_next = S.next(ui + 1, nxt);
        const char* nA = has_next ? (const char*)g.A + (size_t)nxt.pm * tstep : cA; const char* nB = has_next ? (const char*)g.Bt + (size_t)nxt.pn * tstep : cB;
        for (int t = 0; t < nt; t += 2) {
            const bool last = (t == nt - 2);
            const char* a1 = cA + (size_t)(t + 1) * kstep;
            const char* a2 = last ? nA : cA + (size_t)(t + 2) * kstep; const char* b2 = last ? nB : cB + (size_t)(t + 2) * kstep;
            const char* a3 = a2 + kstep; const char* b3 = b2 + kstep;
            if (last && has_next) S.a_ready(nxt);
            if constexpr (SP2) {
            PG8_LDB(B0, 0, 0); PG8_LDB(B1, 0, 1); PG8_SCHED; PG8_LDA(At, 0, 0); PG8_STAGE(PG8_SA(1, 1), a1 + hstep, voffA);
            PG8_WAIT_V(8); PG8_WAIT_L(0); PG8_BAR; PG8_MMA(0, 0, At, B0); PG8_MMA(0, 1, At, B1); PG8_BAR; PG8_SCHED;
            PG8_LDA(At, 0, 1); PG8_STAGE(PG8_SB(0, 0), b2, voffB); PG8_STAGE(PG8_SB(0, 1), b2 + hstep, voffB); PG8_STAGE(PG8_SA(0, 0), a2, voffA);
            PG8_WAIT_V(8); PG8_WAIT_L(0); PG8_BAR; PG8_MMA(1, 0, At, B0); PG8_MMA(1, 1, At, B1); PG8_BAR; PG8_SCHED;
            PG8_LDB(B0, 1, 0); PG8_LDB(B1, 1, 1); PG8_SCHED; PG8_LDA(At, 1, 0); PG8_STAGE(PG8_SA(0, 1), a2 + hstep, voffA);
            PG8_WAIT_V(8); PG8_WAIT_L(0); PG8_BAR; PG8_MMA(0, 0, At, B0); PG8_MMA(0, 1, At, B1); PG8_BAR; PG8_SCHED;
            PG8_LDA(At, 1, 1); PG8_STAGE(PG8_SB(1, 0), b3, voffB); PG8_STAGE(PG8_SB(1, 1), b3 + hstep, voffB); PG8_STAGE(PG8_SA(1, 0), a3, voffA);
            PG8_WAIT_V(8); PG8_WAIT_L(0); PG8_BAR; PG8_MMA(1, 0, At, B0); PG8_MMA(1, 1, At, B1); PG8_BAR; PG8_SCHED;
            } else {
            PG8_LDB(B0, 0, 0); PG8_SCHED; PG8_LDA(At, 0, 0); PG8_STAGE(PG8_SA(1, 1), a1 + hstep, voffA);
            PG8_WAIT_L(8); PG8_BAR; PG8_WAIT_L(0); PG8_MMA(0, 0, At, B0); PG8_BAR; PG8_SCHED;
            PG8_LDB(B1, 0, 1); PG8_STAGE(PG8_SB(0, 0), b2, voffB);
            PG8_BAR; PG8_WAIT_L(0); PG8_MMA(0, 1, At, B1); PG8_BAR;
            PG8_LDA(At, 0, 1); PG8_STAGE(PG8_SA(0, 0), a2, voffA);
            PG8_BAR; PG8_WAIT_L(0); PG8_MMA(1, 0, At, B0); PG8_BAR; PG8_SCHED;
            PG8_STAGE(PG8_SB(0, 1), b2 + hstep, voffB);
            PG8_WAIT_V(6); PG8_BAR; PG8_MMA(1, 1, At, B1); PG8_BAR;
            PG8_LDB(B0, 1, 0); PG8_SCHED; PG8_LDA(At, 1, 0); PG8_STAGE(PG8_SA(0, 1), a2 + hstep, voffA);
            PG8_WAIT_L(8); PG8_BAR; PG8_WAIT_L(0); PG8_MMA(0, 0, At, B0); PG8_BAR; PG8_SCHED;
            PG8_LDB(B1, 1, 1); PG8_STAGE(PG8_SB(1, 0), b3, voffB);
            PG8_BAR; PG8_WAIT_L(0); PG8_MMA(0, 1, At, B1); PG8_BAR;
            PG8_LDA(At, 1, 1); PG8_STAGE(PG8_SA(1, 0), a3, voffA);
            PG8_BAR; PG8_WAIT_L(0); PG8_MMA(1, 0, At, B0); PG8_BAR; PG8_SCHED;
            PG8_STAGE(PG8_SB(1, 1), b3 + hstep, voffB);
            PG8_WAIT_V(6); PG8_BAR; PG8_MMA(1, 1, At, B1); PG8_BAR;
            }
        }
        if constexpr (ALIGN_EPI) { if (wr == 0) PG8_BAR; }
        if constexpr (!Epi::AFTER_DRAIN) { E(acc, cur, wr, wc, fr, fq); S.done(cur); }
        if (!has_next) break;
#pragma unroll
        for (int a = 0; a < 2; ++a)
#pragma unroll
            for (int b = 0; b < 2; ++b)
#pragma unroll
                for (int m = 0; m < 4; ++m)
#pragma unroll
                    for (int n = 0; n < 2; ++n) acc[a][b][m][n] = (f32x4){0.f, 0.f, 0.f, 0.f};
        cur = nxt; cA = nA; cB = nB; ++ui;
        if constexpr (ALIGN_EPI) { if (wr == 1) PG8_BAR; }
    }
    PG8_WAIT_V(0);
    if constexpr (!ALIGN_EPI) { if (wr == 0) PG8_BAR; }
    PG8_BAR;
#undef PG8_SA
#undef PG8_SB
#undef PG8_STAGE
#undef PG8_LDA
#undef PG8_LDB
#undef PG8_MMA
#undef PG8_WAIT_V
#undef PG8_WAIT_L
#undef PG8_BAR
#undef PG8_SCHED
}
}

__device__ __forceinline__ void p0_transpose_item(const float* W, int N, bf16* WT, int ldo, int drow0, LAS float* scr, int kb, int nb, int lane, const float* mu, int mode) {
    const int k0 = 64 * kb, n0 = 32 * nb;
    float wv[32];
#pragma unroll
    for (int i = 0; i < 32; ++i) wv[i] = __builtin_nontemporal_load(W + (size_t)(k0 + 2 * i + (lane >> 5)) * N + n0 + (lane & 31));
#pragma unroll
    for (int i = 0; i < 32; ++i) { const int kk = 2 * i + (lane >> 5); float v = wv[i];
        if (mode) { const float m = mu[k0 + kk]; v *= (mode == 1) ? (1.0f - m) : m; }
        scr[kk * 33 + (lane & 31)] = v; }
    asm volatile("s_waitcnt lgkmcnt(0)" ::: "memory");
    const int c = lane & 7;
#pragma unroll
    for (int j = 0; j < 4; ++j) { const int n = (lane >> 3) + 8 * j; const LAS float* s = scr + (8 * c) * 33 + n;
        u32x4 o; o.x = pk2(s[0 * 33], s[1 * 33]); o.y = pk2(s[2 * 33], s[3 * 33]); o.z = pk2(s[4 * 33], s[5 * 33]); o.w = pk2(s[6 * 33], s[7 * 33]);
        *(u32x4*)(WT + (size_t)(drow0 + n) * ldo + k0 + 8 * c) = o; }
    asm volatile("s_waitcnt lgkmcnt(0)" ::: "memory");
}
__device__ __forceinline__ void modnorm_row2(const float* xrow, bf16* orow, const float* gain, const float* sc, const float* sh, int lane) {
    const f32x4* xr = (const f32x4*)xrow + lane;
    f32x4 v[2][8]; float s0 = 0.f, s1 = 0.f;
#pragma unroll
    for (int j = 0; j < 8; ++j) { v[0][j] = __builtin_nontemporal_load(xr + 64 * j); v[1][j] = __builtin_nontemporal_load(xr + 512 + 64 * j); }
#pragma unroll
    for (int j = 0; j < 8; ++j) { s0 += (v[0][j][0] * v[0][j][0] + v[0][j][1] * v[0][j][1]) + (v[0][j][2] * v[0][j][2] + v[0][j][3] * v[0][j][3]);
                                  s1 += (v[1][j][0] * v[1][j][0] + v[1][j][1] * v[1][j][1]) + (v[1][j][2] * v[1][j][2] + v[1][j][3] * v[1][j][3]); }
    const float r0 = __builtin_amdgcn_rsqf(wave_sum(s0) * (1.0f / DM) + 1e-6f), r1 = __builtin_amdgcn_rsqf(wave_sum(s1) * (1.0f / DM) + 1e-6f);
    u32x2* o8 = (u32x2*)orow + lane;
#pragma unroll
    for (int j = 0; j < 8; ++j) { const f32x4 gm = ((const f32x4*)gain)[lane + 64 * j] * (((const f32x4*)sc)[lane + 64 * j] + 1.0f), b = ((const f32x4*)sh)[lane + 64 * j];
        o8[64 * j] = pk4(v[0][j] * r0 * gm + b); o8[512 + 64 * j] = pk4(v[1][j] * r1 * gm + b); }
}

__device__ __forceinline__ void late_weight_copies(const float* w_out, const float* w_gu, const float* w_dn, bf16* WOT, bf16* WGUT, bf16* WDT, LAS float* scr, int lane, int first, int stride) {
    constexpr int I_O = 32 * 64, I_GU = 32 * 352, I_DN = 88 * 64;
    for (int it = first; it < I_O + I_GU + I_DN; it += stride) { int r = it;
        if (r < I_O) { p0_transpose_item(w_out, DM, WOT, DM, 32 * (r % 64), scr, r / 64, r % 64, lane, nullptr, 0); continue; } r -= I_O;
        if (r < I_GU) { const int nb = r % 352, n0 = 32 * nb; const int drow = (n0 < DFF) ? ((n0 / 128) * 256 + n0 % 128) : (((n0 - DFF) / 128) * 256 + 128 + (n0 - DFF) % 128);
            p0_transpose_item(w_gu, 2 * DFF, WGUT, DM, drow, scr, r / 352, nb, lane, nullptr, 0); continue; }
        r -= I_GU;
        p0_transpose_item(w_dn, DM, WDT, DFF, 32 * (r % 64), scr, r / 64, r % 64, lane, nullptr, 0); }
}

__device__ __forceinline__ void sh2_gemv(const float* mod, const float* w_gu, float* c2, int first, int stride) {
    for (int it = first; it < 32 * 2816; it += stride) { const int kc = it / 2816, n4 = it % 2816;
        f32x4 a0 = {0.f, 0.f, 0.f, 0.f}, a1 = a0, a2 = a0, a3 = a0;
        for (int k0 = 64 * kc; k0 < 64 * kc + 64; k0 += 8) { f32x4 wv[8];
#pragma unroll
            for (int u = 0; u < 8; ++u) wv[u] = *(const f32x4*)(w_gu + (size_t)(k0 + u) * (2 * DFF) + 4 * n4);
#pragma unroll
            for (int u = 0; u < 8; ++u) { const float* sp = mod + 3 * DM + k0 + u; a0 += wv[u] * sp[0]; a1 += wv[u] * sp[NMOD]; a2 += wv[u] * sp[2 * NMOD]; a3 += wv[u] * sp[3 * NMOD]; } }
#pragma unroll
        for (int j = 0; j < 4; ++j) { atomicAdd(c2 + 4 * n4 + j, a0[j]); atomicAdd(c2 + 2 * DFF + 4 * n4 + j, a1[j]); atomicAdd(c2 + 4 * DFF + 4 * n4 + j, a2[j]); atomicAdd(c2 + 6 * DFF + 4 * n4 + j, a3[j]); } }
}

struct PrepPtrs { const bf16* PRKV; bf16* L2O; bf16* SR; bf16* SKT; bf16* SWR; bf16* SREM; bf16* SV; float* BS; const float* mu; const float* pw0; const float* pa0; const float* pkk; const float* pka; const float* prk; };
__device__ __forceinline__ void rwkv_prep(const PrepPtrs& P, int wv, int nwv, int lane, int sel) {
    const bf16* PRKV = P.PRKV; bf16* L2O = P.L2O; bf16* SR = P.SR; bf16* SKT = P.SKT; bf16* SWR = P.SWR; bf16* SREM = P.SREM; bf16* SV = P.SV; float* BS = P.BS;
    const float* mu = P.mu; const float* pw0 = P.pw0; const float* pa0 = P.pa0; const float* pkk = P.pkk; const float* pka = P.pka; const float* prk = P.prk;
    { const int q4 = wv & 3, c = 256 * q4 + 4 * lane, head = 4 * q4 + (lane >> 4);
          const f32x4 mur = *(const f32x4*)(mu + c), muk = *(const f32x4*)(mu + DR + c), muv = *(const f32x4*)(mu + 2 * DR + c);
          const f32x4 w0 = *(const f32x4*)(pw0 + c), a0 = *(const f32x4*)(pa0 + c), kkc = *(const f32x4*)(pkk + c), kac = *(const f32x4*)(pka + c), rkc = *(const f32x4*)(prk + c);
          const int per = (sel == 0) ? SEQ / 16 : (sel == 1) ? 3 * SEQ / 16 : SEQ / 4, goff = (sel == 1) ? SEQ / 16 : 0;
          for (int qi = wv >> 2; qi < BATCH * per; qi += nwv >> 2) { const int tg = (qi / per) * (SEQ / 4) + goff + (qi % per);
              const int t0 = 4 * tg; const bool first = (t0 & (SEQ - 1)) == 0;
              const bf16* pc = PRKV + (size_t)t0 * 3072 + c; const u32x2 z2 = {0u, 0u};
              u32x2 rr[5], rk[5], rv[5], lxw[4], lxa[4];
              if (!first) { rr[0] = *(const u32x2*)(pc - 3072); rk[0] = *(const u32x2*)(pc - 3072 + DR); rv[0] = *(const u32x2*)(pc - 3072 + 2 * DR); } else { rr[0] = z2; rk[0] = z2; rv[0] = z2; }
#pragma unroll
              for (int i = 0; i < 4; ++i) { rr[i + 1] = *(const u32x2*)(pc + (size_t)i * 3072); rk[i + 1] = *(const u32x2*)(pc + (size_t)i * 3072 + DR); rv[i + 1] = *(const u32x2*)(pc + (size_t)i * 3072 + 2 * DR);
                  lxw[i] = *(const u32x2*)(L2O + (size_t)(t0 + i) * 3072 + c); lxa[i] = *(const u32x2*)(L2O + (size_t)(t0 + i) * 3072 + DR + c); }
#pragma unroll
              for (int i = 0; i < 4; ++i) {
                  const f32x4 pr = bf4(rr[i + 1]), pk = bf4(rk[i + 1]), pv = bf4(rv[i + 1]);
                  const f32x4 r = pr + (bf4(rr[i]) - pr) * mur, k = pk + (bf4(rk[i]) - pk) * muk, v = pv + (bf4(rv[i]) - pv) * muv;
                  const f32x4 xw = bf4(lxw[i]), xa = bf4(lxa[i]);
                  f32x4 a, d1;
#pragma unroll
                  for (int j = 0; j < 4; ++j) { a[j] = sigmoidf_(a0[j] + xa[j]); d1[j] = 1.0f - fexp2(-0.6065306597126334f * LOG2E * sigmoidf_(w0[j] + xw[j])); }
                  typedef _Float16 h4 __attribute__((ext_vector_type(4)));
                  const h4 dh = {(_Float16)d1[0], (_Float16)d1[1], (_Float16)d1[2], (_Float16)d1[3]};
                  f32x4 kk = k * kkc; const float ss = allsum16((kk[0] * kk[0] + kk[1] * kk[1]) + (kk[2] * kk[2] + kk[3] * kk[3])); kk = kk * __builtin_amdgcn_rsqf(ss + 1e-12f);
                  const f32x4 kt = k * ((a - 1.0f) * kac + 1.0f), pcv = r * kt * rkc;
                  const float bs = allsum16((pcv[0] + pcv[1]) + (pcv[2] + pcv[3]));
                  const size_t off = (size_t)(t0 + i) * DR + c;
                  *(u32x2*)(SR + off) = pk4(r); *(u32x2*)(SKT + off) = pk4(kt); *(u32x2*)(SWR + off) = pk4(kk * a); *(u32x2*)(SREM + off) = pk4(-kk); *(u32x2*)(SV + off) = pk4(v);
                  *(u32x2*)(L2O + (size_t)(t0 + i) * 3072 + c) = __builtin_bit_cast(u32x2, dh);
                  if ((lane & 15) == 0) BS[(size_t)(t0 + i) * 16 + head] = bs; } } }
}

constexpr int SB_KP = 72, SB_VP = 68;
__device__ __forceinline__ u32x4 sb_knorm(u32x4 raw, const f32x4& g0, const f32x4& g1) {
    const f32x4 a = bf4((u32x2){raw.x, raw.y}), b = bf4((u32x2){raw.z, raw.w});
    float ss = ((a[0] * a[0] + a[1] * a[1]) + (a[2] * a[2] + a[3] * a[3])) + ((b[0] * b[0] + b[1] * b[1]) + (b[2] * b[2] + b[3] * b[3]));
    ss += dppf<0xB1>(ss); ss += dppf<0x4E>(ss); ss += dppf<0x141>(ss);
    const float rs = __builtin_amdgcn_rsqf(ss * (1.0f / 64.0f) + 1e-6f);
    const f32x4 x = a * rs * g0, y = b * rs * g1; const u32x2 p = pk4(x), q = pk4(y);
    return (u32x4){p.x, p.y, q.x, q.y};
}
__device__ __forceinline__ void sb_attn_unit(LAS unsigned char* lds, const bf16* PSB, bf16* YC, const float* gq, const float* gk, int b, int h, int qb) {
    const int tid = threadIdx.x, lane = tid & 63, r32 = lane & 31, hi = lane >> 5; const int wid = __builtin_amdgcn_readfirstlane(tid >> 6);
    LAS bf16* Ks = (LAS bf16*)lds; LAS bf16* Vt = (LAS bf16*)(lds + 64 * SB_KP * 2);
    const int q0 = qb * 256; const size_t rowbase = (size_t)b * SEQ;
    const bf16* Qw = PSB + (rowbase + q0 + wid * 32 + r32) * 3072 + h * 64;
    bf16x8 qr[4];
    { u32x4 qraw[4]; float ss = 0.f;
#pragma unroll
      for (int d0 = 0; d0 < 4; ++d0) { qraw[d0] = *(const u32x4*)(Qw + d0 * 16 + hi * 8); const f32x4 a = bf4((u32x2){qraw[d0].x, qraw[d0].y}), c = bf4((u32x2){qraw[d0].z, qraw[d0].w});
          ss += ((a[0] * a[0] + a[1] * a[1]) + (a[2] * a[2] + a[3] * a[3])) + ((c[0] * c[0] + c[1] * c[1]) + (c[2] * c[2] + c[3] * c[3])); }
      ss += __shfl_xor(ss, 32);
      const float rs = __builtin_amdgcn_rsqf(ss * (1.0f / 64.0f) + 1e-6f) * (0.125f * LOG2E);
#pragma unroll
      for (int d0 = 0; d0 < 4; ++d0) { const f32x4 g0 = *(const f32x4*)(gq + d0 * 16 + hi * 8), g1 = *(const f32x4*)(gq + d0 * 16 + hi * 8 + 4);
          const f32x4 a = bf4((u32x2){qraw[d0].x, qraw[d0].y}) * rs * g0, c = bf4((u32x2){qraw[d0].z, qraw[d0].w}) * rs * g1; const u32x2 p = pk4(a), q = pk4(c);
          qr[d0] = __builtin_bit_cast(bf16x8, (u32x4){p.x, p.y, q.x, q.y}); } }
    half8 L0, L1, ones;
#pragma unroll
    for (int j = 0; j < 8; ++j) { const int kv = 4 * hi + (j & 3) + 8 * (j >> 2); L0[j] = (kv > r32) ? (_Float16)1.0f : (_Float16)0.0f; L1[j] = (kv + 16 > r32) ? (_Float16)1.0f : (_Float16)0.0f; ones[j] = (_Float16)1.0f; }
    f32x16 o[2]; o[0] = f32x16{}; o[1] = f32x16{};
    float R = 0.f; bool done = false;
    const int ldrow = tid >> 3, ch = tid & 7;
    const f32x4 gk0 = *(const f32x4*)(gk + 8 * ch), gk1 = *(const f32x4*)(gk + 8 * ch + 4);
    const bf16* kvsrc = PSB + (rowbase + ldrow) * 3072 + h * 64 + 8 * ch;
    int jt = 4 * qb + 3;
    u32x4 kreg = *(const u32x4*)(kvsrc + (size_t)(64 * jt) * 3072 + 1024), vreg = *(const u32x4*)(kvsrc + (size_t)(64 * jt) * 3072 + 2048);
    const int qabs = q0 + wid * 32 + r32;
    for (; jt >= 0; --jt) {
        *(LAS u32x4*)(Ks + ldrow * SB_KP + 8 * ch) = sb_knorm(kreg, gk0, gk1);
        { const unsigned w[4] = {vreg.x, vreg.y, vreg.z, vreg.w};
#pragma unroll
          for (int j = 0; j < 4; ++j) { Vt[(8 * ch + 2 * j) * SB_VP + ldrow] = (bf16)(w[j] & 0xffffu); Vt[(8 * ch + 2 * j + 1) * SB_VP + ldrow] = (bf16)(w[j] >> 16); } }
        __syncthreads();
        if (jt > 0) { kreg = *(const u32x4*)(kvsrc + (size_t)(64 * (jt - 1)) * 3072 + 1024); vreg = *(const u32x4*)(kvsrc + (size_t)(64 * (jt - 1)) * 3072 + 2048); }
        const bool active = !done && (64 * jt < q0 + 32 * wid + 31);
        if (active) {
            f32x16 p[2];
#pragma unroll
            for (int mb = 0; mb < 2; ++mb) { f32x16 a = f32x16{};
#pragma unroll
                for (int d0 = 0; d0 < 4; ++d0) { const bf16x8 kf = *(const LAS bf16x8*)(Ks + (32 * mb + r32) * SB_KP + 16 * d0 + 8 * hi); a = __builtin_amdgcn_mfma_f32_32x32x16_bf16(kf, qr[d0], a, 0, 0, 0); }
                p[mb] = a; }
            const bool diag = (64 * jt + 63 >= q0 + 32 * wid);
            const int kvb = 64 * jt + 4 * hi;
            float sp[2][16];
#pragma unroll
            for (int mb = 0; mb < 2; ++mb)
#pragma unroll
                for (int r = 0; r < 16; ++r) { const int kv = kvb + (r & 3) + 8 * (r >> 2) + 32 * mb; float s = flog2(1.0f + fexp2(p[mb][r])); if (diag && kv >= qabs) s = 0.f; sp[mb][r] = s; }
            half8 spf[4];
#pragma unroll
            for (int s = 0; s < 4; ++s)
#pragma unroll
                for (int j = 0; j < 8; ++j) spf[s][j] = (_Float16)sp[s >> 1][8 * (s & 1) + j];
            f32x16 T0 = f32x16{}, T1 = f32x16{};
            T0 = __builtin_amdgcn_mfma_f32_32x32x16_f16(L0, spf[0], T0, 0, 0, 0); T0 = __builtin_amdgcn_mfma_f32_32x32x16_f16(L1, spf[1], T0, 0, 0, 0);
            T0 = __builtin_amdgcn_mfma_f32_32x32x16_f16(ones, spf[2], T0, 0, 0, 0); T0 = __builtin_amdgcn_mfma_f32_32x32x16_f16(ones, spf[3], T0, 0, 0, 0);
            T1 = __builtin_amdgcn_mfma_f32_32x32x16_f16(L0, spf[2], T1, 0, 0, 0); T1 = __builtin_amdgcn_mfma_f32_32x32x16_f16(L1, spf[3], T1, 0, 0, 0);
            float tot = T0[0] + sp[0][0];
            tot = __shfl(tot, r32);
            float av[2][16];
#pragma unroll
            for (int r = 0; r < 16; ++r) { const int kv = kvb + (r & 3) + 8 * (r >> 2);
                float a0 = fexp2(p[0][r] - sp[0][r] - T0[r] - R), a1 = fexp2(p[1][r] - sp[1][r] - T1[r] - R);
                if (diag && kv >= qabs) a0 = 0.f; if (diag && kv + 32 >= qabs) a1 = 0.f; av[0][r] = a0; av[1][r] = a1; }
            bf16x8 pa[4];
#pragma unroll
            for (int s = 0; s < 4; ++s) { u32x4 w;
                w.x = pk2(av[s >> 1][8 * (s & 1) + 0], av[s >> 1][8 * (s & 1) + 1]); w.y = pk2(av[s >> 1][8 * (s & 1) + 2], av[s >> 1][8 * (s & 1) + 3]);
                w.z = pk2(av[s >> 1][8 * (s & 1) + 4], av[s >> 1][8 * (s & 1) + 5]); w.w = pk2(av[s >> 1][8 * (s & 1) + 6], av[s >> 1][8 * (s & 1) + 7]);
                pa[s] = __builtin_bit_cast(bf16x8, w); }
#pragma unroll
            for (int nb = 0; nb < 2; ++nb)
#pragma unroll
                for (int s = 0; s < 4; ++s) { const LAS bf16* vp = Vt + (r32 + 32 * nb) * SB_VP + 16 * s + 4 * hi;
                    const u32x2 lo = *(const LAS u32x2*)vp, hi2 = *(const LAS u32x2*)(vp + 8);
                    const u32x4 vv = {lo.x, lo.y, hi2.x, hi2.y};
                    o[nb] = __builtin_amdgcn_mfma_f32_32x32x16_bf16(pa[s], __builtin_bit_cast(bf16x8, vv), o[nb], 0, 0, 0); }
            R += tot;
            if (__all(R > 151.0f)) done = true;
        }
        if (__syncthreads_and(done ? 1 : 0)) break;
    }
    bf16* Ow = YC + (rowbase + q0 + wid * 32) * 2048 + 1024 + h * 64;
#pragma unroll
    for (int r = 0; r < 16; ++r) { const int q = (r & 3) + 8 * (r >> 2) + 4 * hi;
#pragma unroll
        for (int nb = 0; nb < 2; ++nb) Ow[(size_t)q * 2048 + r32 + 32 * nb] = (bf16)f2bf(o[nb][r]); }
}

constexpr int SC_TC = 16, SC_REC = 352;
constexpr int SC_INB = SC_TC * SC_REC;
constexpr int SC_YB = SC_TC * 512;
struct ScanRegs { u32x2 r, k, wr, m, d, v; };
struct ScanPtrs { const bf16* SR; const bf16* SKT; const bf16* SWR; const bf16* SREM; const bf16* SV; const bf16* L2O; };
__device__ __forceinline__ void scan_item(LAS unsigned char* lds, const ScanPtrs& P, bf16* YC, int item, unsigned* half_cnt, unsigned half_expect) {
    const int tid = threadIdx.x, lane = tid & 63; const int wid = __builtin_amdgcn_readfirstlane(tid >> 6);
    const int bh = item >> 1, half = item & 1, b = bh >> 4, h = bh & 15;
    LAS float* inb = (LAS float*)lds;
    LAS float* ypb = inb + 2 * SC_INB;
    const size_t tok0 = (size_t)b * SEQ;
    constexpr int NCH = SEQ / SC_TC;
    if (wid >= 4) {
        const int ltid = tid - 256, tk = ltid >> 4, cgp = ltid & 15;
        const bool isv = (cgp >> 3) == half;
        const size_t offA = (tok0 + tk) * DR + h * 64 + 4 * cgp;
        const bf16* lbase = P.L2O + (tok0 + tk) * 3072 + h * 64 + 4 * cgp;
        bf16* yout0 = YC + (tok0 + (ltid >> 5)) * 2048 + h * 64 + 32 * half + (ltid & 31);
        const int yrot = ((ltid & 31) >> 2) & 3;
        ScanRegs q0, q1;
#define SC_LOAD(Q, c) do { const size_t o_ = offA + (size_t)(c) * SC_TC * DR; (Q).r = *(const u32x2*)(P.SR + o_); (Q).k = *(const u32x2*)(P.SKT + o_); (Q).wr = *(const u32x2*)(P.SWR + o_); \
        (Q).m = *(const u32x2*)(P.SREM + o_); (Q).d = *(const u32x2*)(lbase + (size_t)(c) * SC_TC * 3072); if (isv) (Q).v = *(const u32x2*)(P.SV + o_); } while (0)
#define SC_STORE(Q, bi) do { LAS float* rec = inb + (bi) * SC_INB + tk * SC_REC + 4 * cgp; typedef _Float16 h4_ __attribute__((ext_vector_type(4))); const h4_ dh_ = __builtin_bit_cast(h4_, (Q).d); \
        *(LAS f32x4*)(rec) = (f32x4){1.0f - (float)dh_[0], 1.0f - (float)dh_[1], 1.0f - (float)dh_[2], 1.0f - (float)dh_[3]}; \
        *(LAS f32x4*)(rec + 64) = bf4((Q).m); *(LAS f32x4*)(rec + 128) = bf4((Q).wr); *(LAS f32x4*)(rec + 192) = bf4((Q).k); *(LAS f32x4*)(rec + 256) = bf4((Q).r); \
        if (isv) *(LAS f32x4*)(inb + (bi) * SC_INB + tk * SC_REC + 320 + 4 * (cgp & 7)) = bf4((Q).v); } while (0)
#define SC_YRED(bi, c) do { _Pragma("unroll") for (int hh = 0; hh < 2; ++hh) { const LAS f32x4* yp_ = (const LAS f32x4*)(ypb + (bi) * SC_YB + (ltid + 256 * hh) * 16); \
        const f32x4 a_ = yp_[yrot], b_ = yp_[(yrot + 1) & 3], c_ = yp_[(yrot + 2) & 3], d_ = yp_[(yrot + 3) & 3]; const f32x4 s_ = (a_ + b_) + (c_ + d_); \
        yout0[((size_t)(c) * SC_TC + 8 * hh) * 2048] = (bf16)f2bf((s_[0] + s_[1]) + (s_[2] + s_[3])); } } while (0)
        SC_LOAD(q0, 0); SC_LOAD(q1, 1); SC_STORE(q0, 0); SC_LOAD(q0, 2);
        __syncthreads();
        for (int c = 0; c < NCH; c += 2) {
            if (c == NCH / 4 - 8) {
                unsigned sp_ = 0u; while (xb_ld(half_cnt) < half_expect) { __builtin_amdgcn_s_sleep(8); if (++sp_ > (1u << 20)) break; }
                __builtin_amdgcn_fence(__ATOMIC_ACQUIRE, "agent"); asm volatile("s_waitcnt vmcnt(0)" ::: "memory"); }
            SC_STORE(q1, 1); if (c + 3 < NCH) SC_LOAD(q1, c + 3);
            if (c > 0) SC_YRED(1, c - 1);
            __syncthreads();
            if (c + 2 < NCH) SC_STORE(q0, 0); if (c + 4 < NCH) SC_LOAD(q0, c + 4);
            SC_YRED(0, c);
            __syncthreads();
        }
        SC_YRED(1, NCH - 1);
#undef SC_LOAD
#undef SC_STORE
#undef SC_YRED
    } else {
        const int g = lane & 15, ra = 8 * wid + (lane >> 4);
        f32x2 A01 = {0.f, 0.f}, A23 = {0.f, 0.f}, B01 = {0.f, 0.f}, B23 = {0.f, 0.f};
        __builtin_amdgcn_s_setprio(3);
        __syncthreads();
        for (int c = 0; c < NCH; ++c) {
            const LAS float* Bk = inb + (c & 1) * SC_INB + 4 * g;
            const LAS float* Bv = inb + (c & 1) * SC_INB + 320 + ra;
            LAS float* Y = ypb + (c & 1) * SC_YB + ra * 16 + g;
            f32x4 cw, cm, cwr, ck, cr, nw, nm, nwr, nk, nr; float cva, cvb, nva, nvb;
#define SC_RD(s, W, Mm, WR, Kk, Rr, Va, Vb) do { W = *(const LAS f32x4*)(Bk + (s) * SC_REC); Mm = *(const LAS f32x4*)(Bk + (s) * SC_REC + 64); WR = *(const LAS f32x4*)(Bk + (s) * SC_REC + 128); \
                Kk = *(const LAS f32x4*)(Bk + (s) * SC_REC + 192); Rr = *(const LAS f32x4*)(Bk + (s) * SC_REC + 256); Va = Bv[(s) * SC_REC]; Vb = Bv[(s) * SC_REC + 4]; } while (0)
            SC_RD(0, cw, cm, cwr, ck, cr, cva, cvb);
#pragma unroll
            for (int s = 0; s < SC_TC; ++s) {
                if (s + 1 < SC_TC) SC_RD(s + 1, nw, nm, nwr, nk, nr, nva, nvb);
                __builtin_amdgcn_sched_barrier(0);
                const f32x2 m01 = {cm[0], cm[1]}, m23 = {cm[2], cm[3]}, w01 = {cw[0], cw[1]}, w23 = {cw[2], cw[3]}, wr01 = {cwr[0], cwr[1]}, wr23 = {cwr[2], cwr[3]},
                            k01 = {ck[0], ck[1]}, k23 = {ck[2], ck[3]}, r01 = {cr[0], cr[1]}, r23 = {cr[2], cr[3]};
                f32x2 qa = A01 * m01; qa = __builtin_elementwise_fma(A23, m23, qa);
                f32x2 qb = B01 * m01; qb = __builtin_elementwise_fma(B23, m23, qb);
                float da = qa[0] + qa[1], db = qb[0] + qb[1];
                const f32x2 vka01 = k01 * cva, vka23 = k23 * cva, vkb01 = k01 * cvb, vkb23 = k23 * cvb;
                da += dppf<0xB1>(da);  db += dppf<0xB1>(db);
                da += dppf<0x4E>(da);  db += dppf<0x4E>(db);
                da += dppf<0x141>(da); db += dppf<0x141>(db);
                da += dppf<0x140>(da); db += dppf<0x140>(db);
                const f32x2 sa2 = {da, da}, sb2 = {db, db};
                A01 = __builtin_elementwise_fma(A01, w01, __builtin_elementwise_fma(wr01, sa2, vka01)); A23 = __builtin_elementwise_fma(A23, w23, __builtin_elementwise_fma(wr23, sa2, vka23));
                B01 = __builtin_elementwise_fma(B01, w01, __builtin_elementwise_fma(wr01, sb2, vkb01)); B23 = __builtin_elementwise_fma(B23, w23, __builtin_elementwise_fma(wr23, sb2, vkb23));
                f32x2 ya = A01 * r01; ya = __builtin_elementwise_fma(A23, r23, ya);
                f32x2 yb = B01 * r01; yb = __builtin_elementwise_fma(B23, r23, yb);
                Y[s * 512] = ya[0] + ya[1]; Y[s * 512 + 64] = yb[0] + yb[1];
                __builtin_amdgcn_sched_barrier(0);
                cw = nw; cm = nm; cwr = nwr; ck = nk; cr = nr; cva = nva; cvb = nvb;
            }
#undef SC_RD
            __syncthreads();
        }
        __builtin_amdgcn_s_setprio(0);
    }
}

#define XB_TMO      128
#define XB_XCNT(j)  (256  + 64 * (j))
#define XB_XSUB(j)  (1280 + 64 * (j))
#define XB_XGEN(j)  (2304 + 64 * (j))
#define XB_TOP      3328
#define XB_TOPGEN   3392
#define XCD_BAR_WORDS 3456
#define XB_SPIN_CAP (1u << 18)
__device__ __forceinline__ unsigned xb_xcc_id() { return (unsigned)__builtin_amdgcn_s_getreg((3 << 11) | 20) & 0xFu; }
#define XB_SPIN(cond, bar) do { unsigned _sp = 0; while (cond) { __builtin_amdgcn_s_sleep(1); \
    if ((++_sp & 255u) == 0u) { if (xb_ld(&(bar)[XB_TMO])) break; if (_sp > XB_SPIN_CAP) { atomicAdd(&(bar)[XB_TMO], 1u); break; } } } } while (0)
struct XcdBarrier { unsigned* bar; unsigned x; volatile LAS unsigned* st; };
__device__ __forceinline__ XcdBarrier xcd_barrier_post(unsigned* bar, volatile LAS unsigned* st) {
    XcdBarrier b; b.bar = bar; b.x = xb_xcc_id(); b.st = st;
    if (threadIdx.x == 0) (void)xb_add(&bar[XB_XCNT(b.x)], 1u);
    return b;
}
__device__ __forceinline__ void xcd_barrier_complete(unsigned* bar, unsigned x, unsigned& nloc, unsigned& nx) {
    const unsigned G = gridDim.x * gridDim.y * gridDim.z;
    unsigned sum, cnt, mine, sp = 0u;
    for (;;) {
        sum = 0u; cnt = 0u; mine = 0u;
#pragma unroll
        for (unsigned j = 0; j < 16; ++j) { const unsigned c = xb_ld(&bar[XB_XCNT(j)]); sum += c; cnt += (c > 0u) ? 1u : 0u; mine = (j == x) ? c : mine; }
        if (sum == G) break;
        __builtin_amdgcn_s_sleep(1);
        if ((++sp & 255u) == 0u) { if (xb_ld(&bar[XB_TMO])) break; if (sp > XB_SPIN_CAP) { atomicAdd(&bar[XB_TMO], 1u); break; } }
    }
    nloc = mine > 0u ? mine : 1u; nx = cnt > 0u ? cnt : 1u;
}
__device__ __forceinline__ void xcd_barrier(const XcdBarrier& b) {
    asm volatile("s_waitcnt vmcnt(0)" ::: "memory");
    __syncthreads();
    if (threadIdx.x == 0) {
        unsigned* bar = b.bar;
        __builtin_amdgcn_s_waitcnt(0);
        unsigned nloc = b.st[0], nx = b.st[1];
        if (nloc == 0u) { xcd_barrier_complete(bar, b.x, nloc, nx); b.st[0] = nloc; b.st[1] = nx; }
        const unsigned old = xb_add(&bar[XB_XSUB(b.x)], 1u);
        const unsigned gen = old / nloc;
        if (old + 1u == (gen + 1u) * nloc) {
            __builtin_amdgcn_fence(__ATOMIC_RELEASE, "agent");
            asm volatile("s_waitcnt vmcnt(0)" ::: "memory");
            const unsigned og = xb_add(&bar[XB_TOP], 1u);
            const unsigned tg = og / nx;
            if (og + 1u == (tg + 1u) * nx) xb_add(&bar[XB_TOPGEN], 1u);
            else XB_SPIN(xb_ld(&bar[XB_TOPGEN]) == tg, bar);
            __builtin_amdgcn_fence(__ATOMIC_ACQUIRE, "agent");
            xb_add(&bar[XB_XGEN(b.x)], 1u);
            asm volatile("s_waitcnt vmcnt(0)" ::: "memory");
        } else {
            XB_SPIN(xb_ld(&bar[XB_XGEN(b.x)]) == gen, bar);
            __builtin_amdgcn_fence(__ATOMIC_ACQUIRE, "agent");
            asm volatile("s_waitcnt vmcnt(0)" ::: "memory");
        }
    }
    __syncthreads();
}

struct Args { const float* in[29]; float* out; unsigned char* ws; int ph_lo, ph_hi; };
constexpr int N_PHASES = 12;

__global__ void __launch_bounds__(512, 2) mk_fwd(Args args) {
    extern __shared__ __attribute__((aligned(16))) unsigned char lds_raw[];
    LAS unsigned char* lds = (LAS unsigned char*)lds_raw;
    cg::grid_group grid = cg::this_grid();
    const int wave = __builtin_amdgcn_readfirstlane(threadIdx.x >> 6);
    const int G = gridDim.x, NGW = G * 8, NGT = G * 512;
    unsigned char* ws = args.ws;
    const float* x = args.in[0]; float* out = args.out;
    float* mod = (float*)(ws + WS_CTL);
    bf16* W1T = (bf16*)(ws + WS_W1T); bf16* WOT = (bf16*)(ws + WS_WOT); bf16* WGUT = (bf16*)(ws + WS_WGUT); bf16* WDT = (bf16*)(ws + WS_WDT); bf16* W2T = (bf16*)(ws + WS_W2T);
    bf16* Hb = (bf16*)(ws + WS_H); bf16* PRKV = (bf16*)(ws + WS_PRKV); bf16* PSB = (bf16*)(ws + WS_PSB); bf16* PLORA = (bf16*)(ws + WS_PLORA);
    bf16* HID = (bf16*)(ws + WS_HID); bf16* L2O = (bf16*)(ws + WS_L2O); bf16* ACT = (bf16*)(ws + WS_ACT); bf16* YC = (bf16*)(ws + WS_YCAT);
    float* rowss = (float*)(ws + 256 * 1024); float* c2v = (float*)(ws + 320 * 1024);
    unsigned* hcnt = (unsigned*)(ws + WS_BAR) + 8192;
    bf16* H2 = (bf16*)(ws + WS_L2O);
    float* BS = (float*)(ws + WS_BS);
    bf16* SR = (bf16*)out; bf16* SKT = SR + SCAN_ARR; bf16* SWR = SKT + SCAN_ARR; bf16* SREM = SWR + SCAN_ARR;
    bf16* SV = (bf16*)(ws + WS_SV);
    const int lo = args.ph_lo, hi = args.ph_hi;
#define IN(k) (lo <= (k) && (k) < hi)
    volatile LAS unsigned* MISC = (volatile LAS unsigned*)(lds + 131072 + 64);
    if (threadIdx.x < 16) MISC[threadIdx.x] = 0u;
    __syncthreads();
    XcdBarrier xbar = xcd_barrier_post((unsigned*)(ws + WS_BAR), MISC);
    if (args.ph_lo < 0) grid.sync();
#define SEAM(k) do { if ((k) != 9 && IN(k) && IN((k) + 1)) xcd_barrier(xbar); } while (0)

    if (IN(0)) { PHASE_IDS();
        LAS float* scr = (LAS float*)(lds + wave * 16384);
        const float* w_in = args.in[6]; const float* mu_w = args.in[8]; const float* mu_a = args.in[9]; const float* mu_g = args.in[10];
        const float* w1 = args.in[12]; const float* a1 = args.in[15]; const float* g1 = args.in[17];
        const float* w_out = args.in[26]; const float* w_gu = args.in[27]; const float* w_dn = args.in[28];
        constexpr int I_IN = 32 * 192, I_L = 2 * (64 + 64 + 160);
        constexpr int NITEMS = I_IN + I_L;
        for (int rep = 0; rep < (PROBE == 3 ? 2 : 1); ++rep)
        for (int it = gw; it < NITEMS; it += NGW) {
            int r = it;
            if (r < I_IN) { p0_transpose_item(w_in, 6144, W1T, DM, 32 * (r % 192), scr, r / 192, r % 192, lane, nullptr, 0); continue; } r -= I_IN;
            { const int part = r / NLORA; int q = r % NLORA;
                const int rb = 6144 + part * NLORA;
                if (q < 64) { p0_transpose_item(w1, 64, W1T, DM, rb + 32 * (q % 2), scr, q / 2, q % 2, lane, mu_w, 1 + part); continue; } q -= 64;
                if (q < 64) { p0_transpose_item(a1, 64, W1T, DM, rb + 64 + 32 * (q % 2), scr, q / 2, q % 2, lane, mu_a, 1 + part); continue; } q -= 64;
                p0_transpose_item(g1, 160, W1T, DM, rb + 128 + 32 * (q % 5), scr, q / 5, q % 5, lane, mu_g, 1 + part); }
        }
        if (G < 256) late_weight_copies(w_out, w_gu, w_dn, WOT, WGUT, WDT, scr, lane, gw, NGW);
        for (int i = gtid; i < 192 * DM / 8; i += NGT) ((u32x4*)(W1T + (size_t)6720 * DM))[i] = (u32x4){0u, 0u, 0u, 0u};
        { const float* w2 = args.in[13]; const float* a2 = args.in[16]; const float* g2 = args.in[18];
          for (int i0 = gtid; i0 < 3072 * KH; i0 += 9 * NGT) { float v[9];
#pragma unroll
              for (int e = 0; e < 9; ++e) { const int i = i0 + e * NGT; v[e] = 0.f;
                  if (i < 3072 * KH) { const int row = i / KH, kk = i % KH, seg = row >> 10, c = row & 1023;
                      if (seg == 0) { if (kk < 64) v[e] = w2[kk * DR + c]; } else if (seg == 1) { if (kk >= 64 && kk < 128) v[e] = a2[(kk - 64) * DR + c]; } else { if (kk >= 128 && kk < 288) v[e] = g2[(kk - 128) * DR + c]; } } }
#pragma unroll
              for (int e = 0; e < 9; ++e) { const int i = i0 + e * NGT; if (i < 3072 * KH) W2T[i] = (bf16)f2bf(v[e]); } } }
        { const float* cvec = args.in[1]; const float* w_ada = args.in[2]; const float* b_ada = args.in[3];
          for (int it = gtid; it < 32 * 3072; it += NGT) { const int kc = it / 3072, n4 = it % 3072;
              f32x4 a0 = {0.f, 0.f, 0.f, 0.f}, a1v = a0, a2v = a0, a3v = a0;
              for (int k0 = 64 * kc; k0 < 64 * kc + 64; k0 += 16) { f32x4 wv[16];
#pragma unroll
                  for (int u = 0; u < 16; ++u) wv[u] = __builtin_nontemporal_load((const f32x4*)(w_ada + (size_t)(k0 + u) * NMOD + 4 * n4));
#pragma unroll
                  for (int u = 0; u < 16; ++u) { const int k = k0 + u; const float c0 = cvec[k], c1 = cvec[DM + k], c2 = cvec[2 * DM + k], c3 = cvec[3 * DM + k];
                      a0 += wv[u] * (c0 * sigmoidf_(c0)); a1v += wv[u] * (c1 * sigmoidf_(c1)); a2v += wv[u] * (c2 * sigmoidf_(c2)); a3v += wv[u] * (c3 * sigmoidf_(c3)); } }
              if (kc == 0) { const f32x4 bv = *(const f32x4*)(b_ada + 4 * n4); a0 += bv; a1v += bv; a2v += bv; a3v += bv; }
#pragma unroll
              for (int j = 0; j < 4; ++j) { atomicAdd(mod + 4 * n4 + j, a0[j]); atomicAdd(mod + NMOD + 4 * n4 + j, a1v[j]); atomicAdd(mod + 2 * NMOD + 4 * n4 + j, a2v[j]); atomicAdd(mod + 3 * NMOD + 4 * n4 + j, a3v[j]); } } }
    }
    SEAM(0);
    if (IN(1)) { PHASE_IDS(); const float* g1n = args.in[4];
        if (G < 256) sh2_gemv(mod, args.in[27], c2v, gtid, NGT);
        for (int m = 2 * gw; m < MTOK; m += 2 * NGW) { const float* mb = mod + (size_t)(m >> 12) * NMOD; modnorm_row2(x + (size_t)m * DM, Hb + (size_t)m * DM, g1n, mb + DM, mb, lane); } }
    SEAM(1);
    if (IN(2)) { pg8::Gemm g{Hb, W1T, MTOK, NP1, DM}; pg8::StaticOrder S; S.init(MTOK, NP1, G, (int)blockIdx.x);
        pg8::EpiStore E{PRKV, PSB, PLORA, 12, 24, 3072, 3072, 768};
        pg8::gemm_phase<pg8::EpiStore, pg8::StaticOrder, true, true>(lds, g, S, E); }
    SEAM(2);
    if (IN(3)) { PHASE_IDS();
        for (int it0 = gtid; it0 < MTOK * 48; it0 += 2 * NGT) {
            u32x4 ua[2], ub[2]; int tt[2], jj[2]; bool ok[2];
#pragma unroll
            for (int e = 0; e < 2; ++e) { const int it = it0 + e * NGT; ok[e] = it < MTOK * 48; tt[e] = it / 48; jj[e] = it % 48; ua[e] = (u32x4){0u, 0u, 0u, 0u}; ub[e] = ua[e];
                if (ok[e] && jj[e] < 36) { ua[e] = *(const u32x4*)(PLORA + (size_t)tt[e] * 768 + 8 * jj[e]);
                    if ((tt[e] & (SEQ - 1)) != 0) ub[e] = *(const u32x4*)(PLORA + (size_t)(tt[e] - 1) * 768 + NLORA + 8 * jj[e]); } }
#pragma unroll
            for (int e = 0; e < 2; ++e) { if (!ok[e]) continue; const int j = jj[e]; u32x4 o = {0u, 0u, 0u, 0u};
                if (j < 36) { const unsigned a4[4] = {ua[e].x, ua[e].y, ua[e].z, ua[e].w}, b4[4] = {ub[e].x, ub[e].y, ub[e].z, ub[e].w}; unsigned r4[4];
#pragma unroll
                    for (int q = 0; q < 4; ++q) { float v0 = bflo(a4[q]) + bflo(b4[q]), v1 = bfhi(a4[q]) + bfhi(b4[q]);
                        if (j < 8) { v0 = 1.0f - 2.0f * frcp(1.0f + fexp2(2.0f * LOG2E * v0)); v1 = 1.0f - 2.0f * frcp(1.0f + fexp2(2.0f * LOG2E * v1)); }
                        else if (j >= 16) { v0 = sigmoidf_(v0); v1 = sigmoidf_(v1); }
                        r4[q] = pk2(v0, v1); }
                    o = (u32x4){r4[0], r4[1], r4[2], r4[3]}; }
                *(u32x4*)(HID + (size_t)tt[e] * KH + 8 * j) = o; } } }
    SEAM(3);
    if (IN(4)) { pg8::Gemm g{HID, W2T, MTOK, 3072, KH}; pg8::StaticOrder S; S.init(MTOK, 3072, G, (int)blockIdx.x);
        pg8::EpiStore E{L2O, L2O, L2O, 1000, 1000, 3072, 3072, 3072};
        pg8::gemm_phase<pg8::EpiStore, pg8::StaticOrder, true, true>(lds, g, S, E); }
    SEAM(4);
    if (IN(5)) { PHASE_IDS();
        { const PrepPtrs PP{PRKV, L2O, SR, SKT, SWR, SREM, SV, BS, args.in[7], args.in[11], args.in[14], args.in[19], args.in[20], args.in[21]};
          rwkv_prep(PP, gw, NGW, lane, (G >= 256) ? 0 : 2); }
    }
    SEAM(5);
    if (IN(6)) { PHASE_IDS();
        { ScanPtrs SP{SR, SKT, SWR, SREM, SV, L2O};
          const bool split = (G >= 256);
          const int sstride = split ? 128 : G;
          if (!split || blockIdx.x < 128)
              for (int rep = 0; rep < (PROBE == 1 ? 2 : 1); ++rep) for (int item = blockIdx.x; item < 128; item += sstride) { scan_item(lds, SP, YC, item, hcnt, split ? (unsigned)(G - 128) : 0u); __syncthreads(); }
          if (!split || blockIdx.x >= 128) { const int ablk = split ? (int)blockIdx.x - 128 : (int)blockIdx.x, astride = split ? G - 128 : G;
              if (split) {
                  const PrepPtrs PP{PRKV, L2O, SR, SKT, SWR, SREM, SV, BS, args.in[7], args.in[11], args.in[14], args.in[19], args.in[20], args.in[21]};
                  rwkv_prep(PP, ablk * 8 + wave, astride * 8, lane, 1);
                  asm volatile("s_waitcnt vmcnt(0)" ::: "memory"); __syncthreads();
                  if (threadIdx.x == 0) { __builtin_amdgcn_fence(__ATOMIC_RELEASE, "agent"); asm volatile("s_waitcnt vmcnt(0)" ::: "memory"); xb_add(hcnt, 1u); }
                  __syncthreads(); }
              for (int rep = 0; rep < (PROBE == 2 ? 2 : 1); ++rep) for (int u = ablk; u < 1024; u += astride) { sb_attn_unit(lds, PSB, YC, args.in[24], args.in[25], u >> 8, (u >> 4) & 15, u & 15); __syncthreads(); }
              if (split) { late_weight_copies(args.in[26], args.in[27], args.in[28], WOT, WGUT, WDT, (LAS float*)(lds + wave * 16384), lane, ablk * 8 + wave, astride * 8);
                  sh2_gemv(mod, args.in[27], c2v, ablk * 512 + tid, astride * 512); } } }
    }
    SEAM(6);
    if (IN(7)) { PHASE_IDS(); const int q4 = gw & 3, c = 256 * q4 + 4 * lane;
        const f32x4 lng = *(const f32x4*)(args.in[22] + c), lnb = *(const f32x4*)(args.in[23] + c);
        const int head = 4 * q4 + (lane >> 4);
        for (int tg = gw >> 2; tg < MTOK / 8; tg += NGW >> 2) {
            u32x2 ly[8], lv[8], lg[8]; float lb[8];
            const int t0 = 8 * tg;
#pragma unroll
            for (int i = 0; i < 8; ++i) { const int t = t0 + i;
                ly[i] = *(const u32x2*)(YC + (size_t)t * 2048 + c); lv[i] = *(const u32x2*)(SV + (size_t)t * DR + c); lg[i] = *(const u32x2*)(L2O + (size_t)t * 3072 + 2 * DR + c); lb[i] = BS[(size_t)t * 16 + head]; }
#pragma unroll
            for (int i = 0; i < 8; ++i) { const int t = t0 + i;
                const f32x4 y = bf4(ly[i]), v = bf4(lv[i]), gg = bf4(lg[i]);
                const float mean = allsum16((y[0] + y[1]) + (y[2] + y[3])) * (1.0f / 64.0f);
                const f32x4 dy = y - mean; const float var = allsum16((dy[0] * dy[0] + dy[1] * dy[1]) + (dy[2] * dy[2] + dy[3] * dy[3])) * (1.0f / 64.0f);
                const f32x4 o = (dy * __builtin_amdgcn_rsqf(var + 64e-5f) * lng + lnb + v * lb[i]) * gg;
                *(u32x2*)(YC + (size_t)t * 2048 + c) = pk4(o); } } }
    SEAM(7);
    if (IN(8)) { pg8::Gemm g{YC, WOT, MTOK, DM, DM}; pg8::StaticOrder S; S.init(MTOK, DM, G, (int)blockIdx.x);
        pg8::EpiResH2 E{x, out, mod, args.in[5], H2, rowss};
        pg8::gemm_phase<pg8::EpiResH2, pg8::StaticOrder, true, true>(lds, g, S, E); }
    SEAM(8);
    SEAM(9);
    if (IN(10)) { pg8::Gemm g{H2, WGUT, MTOK, 2 * DFF, DM}; pg8::StaticOrder S; S.init(MTOK, 2 * DFF, G, (int)blockIdx.x);
        pg8::EpiSwiGLU E{ACT, rowss, c2v};
        for (int rep = 0; rep < (PROBE == 4 ? 2 : 1); ++rep) pg8::gemm_phase<pg8::EpiSwiGLU, pg8::StaticOrder, true, true>(lds, g, S, E); }
    SEAM(10);
    if (IN(11)) { pg8::Gemm g{ACT, WDT, MTOK, DM, DFF}; pg8::StaticOrder S; S.init(MTOK, DM, G, (int)blockIdx.x);
        pg8::EpiRes E{out, out, mod + 5 * DM};
        pg8::gemm_phase<pg8::EpiRes, pg8::StaticOrder, true, true>(lds, g, S, E); }
#undef IN
#undef SEAM
}

#ifndef MK_N_LAUNCHES
#define MK_N_LAUNCHES 1
#endif
extern "C" void kernel_launch(void* const* d_in, const int* in_sizes, int n_in, void* d_out, int out_size, void* d_ws, size_t ws_size, hipStream_t stream) {
    static int grid = 0;
    if (grid == 0) {
        if (n_in != 29 || in_sizes[0] != MTOK * DM || out_size != MTOK * DM || ws_size < WS_END) { fprintf(stderr, "kernel_launch: unexpected shapes / workspace (n_in %d, ws %zu, need %zu)\n", n_in, ws_size, (size_t)WS_END); grid = -1; return; }
        int dev = 0, cus = 0, per_cu = 0;
        if (hipGetDevice(&dev) != hipSuccess || hipDeviceGetAttribute(&cus, hipDeviceAttributeMultiprocessorCount, dev) != hipSuccess) { grid = -1; return; }
        if (hipFuncSetAttribute((const void*)mk_fwd, hipFuncAttributeMaxDynamicSharedMemorySize, LDS_BYTES) != hipSuccess) { fprintf(stderr, "kernel_launch: hipFuncSetAttribute failed\n"); grid = -1; return; }
        if (hipOccupancyMaxActiveBlocksPerMultiprocessor(&per_cu, (const void*)mk_fwd, 512, LDS_BYTES) != hipSuccess || per_cu < 1) { fprintf(stderr, "kernel_launch: occupancy query says %d blocks per CU\n", per_cu); per_cu = 1; }
        (void)hipGetLastError();
        grid = cus;
    }
    if (grid < 0) return;
    (void)hipMemsetAsync((char*)d_ws + WS_CTL, 0, CTL_ZERO_BYTES, stream);
    Args a{};
    for (int i = 0; i < 29; ++i) a.in[i] = (const float*)d_in[i];
    a.out = (float*)d_out; a.ws = (unsigned char*)d_ws;
#if MK_N_LAUNCHES == 1
    a.ph_lo = 0; a.ph_hi = N_PHASES;
    void* kargs[] = {&a};
    hipError_t e = hipLaunchCooperativeKernel((const void*)mk_fwd, dim3(grid), dim3(512), kargs, LDS_BYTES, stream);
    if (e != hipSuccess) fprintf(stderr, "cooperative launch failed: %s (grid %d)\n", hipGetErrorString(e), grid);
#else
    for (int p = 0; p < N_PHASES; ++p) { a.ph_lo = p; a.ph_hi = p + 1; hipLaunchKernelGGL(mk_fwd, dim3(grid), dim3(512), LDS_BYTES, stream, a); }
#endif
}
```

```cpp
#include <hip/hip_runtime.h>
#include <hip/hip_cooperative_groups.h>
#include <cstdio>
#include <cstdint>
namespace cg = cooperative_groups;

#define LAS __attribute__((address_space(3)))
typedef unsigned short bf16;
typedef short bf16x8 __attribute__((ext_vector_type(8)));
typedef _Float16 half8 __attribute__((ext_vector_type(8)));
typedef float f32x4 __attribute__((ext_vector_type(4)));
typedef float f32x2 __attribute__((ext_vector_type(2)));
typedef float f32x16 __attribute__((ext_vector_type(16)));
typedef unsigned u32x4 __attribute__((ext_vector_type(4)));
typedef unsigned u32x2 __attribute__((ext_vector_type(2)));

constexpr int BATCH = 4, SEQ = 4096, DM = 2048, MTOK = BATCH * SEQ, NH = 16, HD = 64, DR = 1024, DFF = 5632;
constexpr int NLORA = 288, NP1 = 6912, KH = 384, NMOD = 6 * DM;
constexpr float LOG2E = 1.4426950408889634f;

constexpr size_t MiB = 1u << 20;
constexpr size_t WS_CTL = 0, CTL_ZERO_BYTES = 1 * MiB, WS_BAR = 512 * 1024;
constexpr size_t WS_W1T = 1 * MiB, WS_WOT = 28 * MiB, WS_WGUT = 36 * MiB, WS_WDT = 80 * MiB, WS_W2T = 102 * MiB;
constexpr size_t WS_H = 105 * MiB, WS_PRKV = 169 * MiB, WS_PSB = 265 * MiB, WS_PLORA = 361 * MiB, WS_HID = 385 * MiB, WS_L2O = 397 * MiB, WS_BS = 493 * MiB, WS_END = 496 * MiB;
constexpr size_t WS_ACT = WS_PRKV, WS_YCAT = WS_H;
constexpr size_t WS_SV = WS_PLORA;
constexpr size_t WS_AB = 494 * MiB;
constexpr size_t SCAN_ARR = (size_t)MTOK * DR;
constexpr int LDS_BYTES = 132096;
#ifndef MK_PROBE
#define MK_PROBE 0
#endif
constexpr int PROBE = MK_PROBE;

__device__ __forceinline__ unsigned f2bf(float f) { unsigned u = __builtin_bit_cast(unsigned, f); return (u + 0x7fffu + ((u >> 16) & 1u)) >> 16; }
__device__ __forceinline__ unsigned pk2(float lo, float hi) { unsigned r; asm volatile("v_cvt_pk_bf16_f32 %0, %1, %2" : "=v"(r) : "v"(lo), "v"(hi)); return r; }
__device__ __forceinline__ float bflo(unsigned u) { return __builtin_bit_cast(float, u << 16); }
__device__ __forceinline__ float bfhi(unsigned u) { return __builtin_bit_cast(float, u & 0xffff0000u); }
__device__ __forceinline__ f32x4 bf4(u32x2 u) { return (f32x4){bflo(u.x), bfhi(u.x), bflo(u.y), bfhi(u.y)}; }
__device__ __forceinline__ u32x2 pk4(f32x4 v) { u32x2 r; r.x = pk2(v[0], v[1]); r.y = pk2(v[2], v[3]); return r; }
__device__ __forceinline__ float fexp2(float x) { return __builtin_amdgcn_exp2f(x); }
__device__ __forceinline__ float flog2(float x) { return __builtin_amdgcn_logf(x); }
__device__ __forceinline__ float frcp(float x) { return __builtin_amdgcn_rcpf(x); }
__device__ __forceinline__ float sigmoidf_(float x) { return frcp(1.0f + fexp2(-x * LOG2E)); }
template <int CTRL> __device__ __forceinline__ float dppf(float x) { return __builtin_bit_cast(float, __builtin_amdgcn_update_dpp(0, __builtin_bit_cast(int, x), CTRL, 0xf, 0xf, true)); }
__device__ __forceinline__ float allsum16(float x) { x += dppf<0xB1>(x); x += dppf<0x4E>(x); x += dppf<0x141>(x); x += dppf<0x140>(x); return x; }
__device__ __forceinline__ float wave_sum(float v) {
#pragma unroll
    for (int o = 1; o < 64; o <<= 1) v += __shfl_xor(v, o);
    return v;
}

__device__ __forceinline__ int tid_opaque() { int t = threadIdx.x; asm volatile("" : "+v"(t)); return t; }
#define PHASE_IDS() const int tid = tid_opaque(), lane = tid & 63; const int gw = blockIdx.x * 8 + wave, gtid = blockIdx.x * 512 + tid; (void)lane; (void)gw; (void)gtid
__device__ __forceinline__ unsigned xb_ld(unsigned* p)              { return __hip_atomic_load(p, __ATOMIC_RELAXED, __HIP_MEMORY_SCOPE_AGENT); }
__device__ __forceinline__ unsigned xb_add(unsigned* p, unsigned v) { return __hip_atomic_fetch_add(p, v, __ATOMIC_RELAXED, __HIP_MEMORY_SCOPE_AGENT); }
namespace pg8 {
typedef unsigned short bf16_t;
constexpr int BM = 256, BK = 64, HALF = 128, HTB = HALF * BK * 2, STAGE_BYTES = 8 * HTB, NXCD = 8, WGM = 4;
__host__ __device__ __forceinline__ int lds_byte(int r, int c) { const int st = (r >> 4) * 2 + (c >> 5), rr = r & 15, cc = c & 31, ob = rr * 64 + cc * 2; return st * 1024 + (ob ^ (((ob >> 9) & 1) << 5)); }
__host__ __device__ __forceinline__ void stage_rc(int b, int& R, int& C) { const int st = b / 1024, sb = b % 1024, swz = sb ^ (((sb >> 9) & 1) << 5); R = (st >> 1) * 16 + swz / 64; C = (st & 1) * 32 + (swz % 64) / 2; }
__host__ __device__ __forceinline__ int perm32(int rho) { const int n = rho >> 4, i = rho & 15; return 8 * (i >> 2) + 4 * n + (i & 3); }
struct Unit { int pm, pn; };
struct Gemm { const bf16_t* A; const bf16_t* Bt; int M, N, K; int lda, ldb; };
struct StaticOrder {
    int nM, nN, nwg, G, c;
    __host__ __device__ void init(int M, int N, int G_, int c_) { nM = M / BM; nN = N / BM; nwg = nM * nN; G = G_; c = c_; }
    __host__ __device__ bool next(int i, Unit& u) const {
        const long L = (long)i * G + c; if (L >= nwg) return false;
        int wgid = (int)L; { const int q = nwg / NXCD, r = nwg % NXCD, xcd = wgid % NXCD, off = wgid / NXCD; wgid = (xcd < r ? xcd * (q + 1) : r * (q + 1) + (xcd - r) * q) + off; }
        const int nig = WGM * nN, gid = wgid / nig, fm = gid * WGM, gsz = (nM - fm) < WGM ? (nM - fm) : WGM;
        u.pm = fm + ((wgid % nig) % gsz); u.pn = (wgid % nig) / gsz; return true;
    }
    __device__ __forceinline__ void a_ready(const Unit&) const {}
    __device__ __forceinline__ void done(const Unit&) const {}
};

struct EpiStore {
    static constexpr bool PERM = true, AFTER_DRAIN = false;
    bf16_t* O0; bf16_t* O1; bf16_t* O2; int t1, t2; int ld0, ld1, ld2;
    __device__ __forceinline__ void operator()(const f32x4 (&acc)[2][2][4][2], const Unit& u, int wr, int wc, int fr, int fq) const {
        bf16_t* base; int ldc, pn = u.pn;
        if (pn < t1) { base = O0; ldc = ld0; } else if (pn < t2) { base = O1; ldc = ld1; pn -= t1; } else { base = O2; ldc = ld2; pn -= t2; }
        const int row0 = u.pm * BM + wr * 64 + fr, col0 = pn * BM + wc * 32 + 8 * fq;
#pragma unroll
        for (int ai = 0; ai < 2; ++ai)
#pragma unroll
            for (int m = 0; m < 4; ++m) { bf16_t* rowp = base + (size_t)(row0 + ai * HALF + m * 16) * ldc + col0;
#pragma unroll
                for (int bj = 0; bj < 2; ++bj) { const f32x4 v0 = acc[ai][bj][m][0], v1 = acc[ai][bj][m][1];
                    u32x4 w; w.x = pk2(v0[0], v0[1]); w.y = pk2(v0[2], v0[3]); w.z = pk2(v1[0], v1[1]); w.w = pk2(v1[2], v1[3]);
                    *(u32x4*)(rowp + bj * HALF) = w; } }
    }
};
struct EpiRes {
    static constexpr bool PERM = true, AFTER_DRAIN = false;
    const float* base; float* out; const float* gate;
    __device__ __forceinline__ void operator()(const f32x4 (&acc)[2][2][4][2], const Unit& u, int wr, int wc, int fr, int fq) const {
        const int row0 = u.pm * BM + wr * 64 + fr, col0 = u.pn * BM + wc * 32 + 8 * fq, b = u.pm >> 4;
#pragma unroll
        for (int bj = 0; bj < 2; ++bj) { const int c = col0 + bj * HALF;
            const f32x4 gv0 = *(const f32x4*)(gate + (size_t)b * NMOD + c), gv1 = *(const f32x4*)(gate + (size_t)b * NMOD + c + 4);
#pragma unroll
            for (int ai = 0; ai < 2; ++ai) { f32x4 bs[4][2];
#pragma unroll
                for (int m = 0; m < 4; ++m) { const float* p = base + (size_t)(row0 + ai * HALF + m * 16) * DM + c; bs[m][0] = *(const f32x4*)p; bs[m][1] = *(const f32x4*)(p + 4); }
#pragma unroll
                for (int m = 0; m < 4; ++m) { float* o = out + (size_t)(row0 + ai * HALF + m * 16) * DM + c;
                    *(f32x4*)o = bs[m][0] + gv0 * acc[ai][bj][m][0]; *(f32x4*)(o + 4) = bs[m][1] + gv1 * acc[ai][bj][m][1]; }
                asm volatile("" ::: "memory"); } }
    }
};
struct EpiResH2 {
    static constexpr bool PERM = true, AFTER_DRAIN = false;
    const float* base; float* out; const float* mod; const float* g2; bf16_t* h2; float* rowss;
    __device__ __forceinline__ void operator()(const f32x4 (&acc)[2][2][4][2], const Unit& u, int wr, int wc, int fr, int fq) const {
        const int row0 = u.pm * BM + wr * 64 + fr, col0 = u.pn * BM + wc * 32 + 8 * fq; const float* mb = mod + (size_t)(u.pm >> 4) * NMOD;
        float ssacc[2][4];
#pragma unroll
        for (int ai = 0; ai < 2; ++ai)
#pragma unroll
            for (int m = 0; m < 4; ++m) ssacc[ai][m] = 0.f;
#pragma unroll
        for (int bj = 0; bj < 2; ++bj) { const int c = col0 + bj * HALF;
            const f32x4 gv0 = *(const f32x4*)(mb + 2 * DM + c), gv1 = *(const f32x4*)(mb + 2 * DM + c + 4);
            const f32x4 gm0 = *(const f32x4*)(g2 + c) * (*(const f32x4*)(mb + 4 * DM + c) + 1.0f), gm1 = *(const f32x4*)(g2 + c + 4) * (*(const f32x4*)(mb + 4 * DM + c + 4) + 1.0f);
#pragma unroll
            for (int ai = 0; ai < 2; ++ai) { f32x4 bs[4][2];
#pragma unroll
                for (int m = 0; m < 4; ++m) { const float* p = base + (size_t)(row0 + ai * HALF + m * 16) * DM + c; bs[m][0] = *(const f32x4*)p; bs[m][1] = *(const f32x4*)(p + 4); }
#pragma unroll
                for (int m = 0; m < 4; ++m) { const size_t off = (size_t)(row0 + ai * HALF + m * 16) * DM + c;
                    const f32x4 x0 = bs[m][0] + gv0 * acc[ai][bj][m][0], x1 = bs[m][1] + gv1 * acc[ai][bj][m][1];
                    *(f32x4*)(out + off) = x0; *(f32x4*)(out + off + 4) = x1;
                    const u32x2 p0 = pk4(x0 * gm0), p1 = pk4(x1 * gm1); *(u32x4*)(h2 + off) = (u32x4){p0.x, p0.y, p1.x, p1.y};
                    ssacc[ai][m] += ((x0[0] * x0[0] + x0[1] * x0[1]) + (x0[2] * x0[2] + x0[3] * x0[3])) + ((x1[0] * x1[0] + x1[1] * x1[1]) + (x1[2] * x1[2] + x1[3] * x1[3])); }
                asm volatile("" ::: "memory"); } }
#pragma unroll
        for (int ai = 0; ai < 2; ++ai)
#pragma unroll
            for (int m = 0; m < 4; ++m) { float sv = ssacc[ai][m]; sv += __shfl_xor(sv, 16); sv += __shfl_xor(sv, 32);
                if (fq == 0) atomicAdd(rowss + row0 + ai * HALF + m * 16, sv); }
    }
};
struct EpiSwiGLU {
    static constexpr bool PERM = true, AFTER_DRAIN = false;
    bf16_t* O; const float* rowss; const float* c2;
    __device__ __forceinline__ void operator()(const f32x4 (&acc)[2][2][4][2], const Unit& u, int wr, int wc, int fr, int fq) const {
        const int row0 = u.pm * BM + wr * 64 + fr, col0 = u.pn * HALF + wc * 32 + 8 * fq; const float* cb = c2 + (size_t)(u.pm >> 4) * (2 * DFF) + col0;
        const f32x4 cg[2] = {*(const f32x4*)cb, *(const f32x4*)(cb + 4)}, cu[2] = {*(const f32x4*)(cb + DFF), *(const f32x4*)(cb + DFF + 4)};
#pragma unroll
        for (int ai = 0; ai < 2; ++ai)
#pragma unroll
            for (int m = 0; m < 4; ++m) { bf16_t* rowp = O + (size_t)(row0 + ai * HALF + m * 16) * DFF + col0; float v[8];
                const float rs = __builtin_amdgcn_rsqf(rowss[row0 + ai * HALF + m * 16] * (1.0f / DM) + 1e-6f);
#pragma unroll
                for (int n = 0; n < 2; ++n)
#pragma unroll
                    for (int j = 0; j < 4; ++j) { const float g = __builtin_fmaf(rs, acc[ai][0][m][n][j], cg[n][j]), up = __builtin_fmaf(rs, acc[ai][1][m][n][j], cu[n][j]); v[4 * n + j] = g * sigmoidf_(g) * up; }
                u32x4 w; w.x = pk2(v[0], v[1]); w.y = pk2(v[2], v[3]); w.z = pk2(v[4], v[5]); w.w = pk2(v[6], v[7]);
                *(u32x4*)rowp = w; }
    }
};

template <class Epi, class Sched, bool ALIGN_EPI = false, bool SP2 = false>
__device__ __forceinline__ void gemm_phase(LAS unsigned char* lds, const Gemm g, const Sched& S, const Epi& E) {
    const int tid = threadIdx.x, wid = __builtin_amdgcn_readfirstlane(tid >> 6), lane = tid & 63, wr = wid >> 2, wc = wid & 3, fr = lane & 15, fq = lane >> 4;
    const int K = g.K, nt = K / BK, lda = g.lda ? g.lda : K, ldb = g.ldb ? g.ldb : K;
    unsigned voffA[2], voffB[2];
#pragma unroll
    for (int i = 0; i < 2; ++i) { int R, C; stage_rc(tid * 16 + i * 8192, R, C); const int Rb = Epi::PERM ? ((R & ~31) + perm32(R & 31)) : R;
        voffA[i] = (unsigned)(R * lda + C) * 2u; voffB[i] = (unsigned)(Rb * ldb + C) * 2u; }
    const size_t kstep = (size_t)(BK * 2);
    const size_t hstepA = (size_t)HALF * lda * 2, hstepB = (size_t)HALF * ldb * 2;
    const size_t tstepA = 2 * hstepA, tstepB = 2 * hstepB;
    const unsigned ldsw = (unsigned)wid * 1024u;
    const int aoff = lds_byte(wr * 64 + fr, fq * 8), boff = lds_byte(wc * 32 + fr, fq * 8);
#define PG8_SA(b, h) (((b) * 2 + (h)) * HTB)
#define PG8_SB(b, h) ((4 + (b) * 2 + (h)) * HTB)
#define PG8_STAGE(bufoff, gbase, voff) do { _Pragma("unroll") for (int _i = 0; _i < 2; ++_i) \
        __builtin_amdgcn_global_load_lds((const unsigned*)((const char*)(gbase) + (voff)[_i]), (LAS unsigned*)(lds + (bufoff) + ldsw + _i * 8192), 16, 0, 0); } while (0)
#define PG8_LDA(dst, b, h) do { _Pragma("unroll") for (int m = 0; m < 4; ++m) _Pragma("unroll") for (int k = 0; k < 2; ++k) dst[m][k] = *(const LAS bf16x8*)(lds + PG8_SA(b, h) + aoff + m * 2048 + k * 1024); } while (0)
#define PG8_LDB(dst, b, h) do { _Pragma("unroll") for (int n = 0; n < 2; ++n) _Pragma("unroll") for (int k = 0; k < 2; ++k) dst[n][k] = *(const LAS bf16x8*)(lds + PG8_SB(b, h) + boff + n * 2048 + k * 1024); } while (0)
#define PG8_MMA(ai, bj, At, Bt) do { __builtin_amdgcn_s_setprio(1); _Pragma("unroll") for (int m = 0; m < 4; ++m) _Pragma("unroll") for (int n = 0; n < 2; ++n) _Pragma("unroll") for (int k = 0; k < 2; ++k) \
        acc[ai][bj][m][n] = __builtin_amdgcn_mfma_f32_16x16x32_bf16(Bt[n][k], At[m][k], acc[ai][bj][m][n], 0, 0, 0); __builtin_amdgcn_s_setprio(0); } while (0)
#define PG8_WAIT_V(n) asm volatile("s_waitcnt vmcnt(" #n ")" ::: "memory")
#define PG8_WAIT_L(n) asm volatile("s_waitcnt lgkmcnt(" #n ")" ::: "memory")
#define PG8_BAR __builtin_amdgcn_s_barrier()
#define PG8_SCHED __builtin_amdgcn_sched_barrier(0)
    Unit cur, nxt; int ui = 0;
    if (!S.next(0, cur)) return;
    f32x4 acc[2][2][4][2];
#pragma unroll
    for (int a = 0; a < 2; ++a)
#pragma unroll
        for (int b = 0; b < 2; ++b)
#pragma unroll
            for (int m = 0; m < 4; ++m)
#pragma unroll
                for (int n = 0; n < 2; ++n) acc[a][b][m][n] = (f32x4){0.f, 0.f, 0.f, 0.f};
    bf16x8 At[4][2], B0[2][2], B1[2][2];
    const char* cA = (const char*)g.A + (size_t)cur.pm * tstepA; const char* cB = (const char*)g.Bt + (size_t)cur.pn * tstepB;
    S.a_ready(cur);
    if constexpr (SP2) {
        PG8_STAGE(PG8_SB(0, 0), cB, voffB); PG8_STAGE(PG8_SB(0, 1), cB + hstepB, voffB); PG8_STAGE(PG8_SA(0, 0), cA, voffA); PG8_STAGE(PG8_SA(0, 1), cA + hstepA, voffA);
        if (wr == 1) PG8_BAR;
        PG8_WAIT_V(2); PG8_BAR;
        PG8_STAGE(PG8_SB(1, 0), cB + kstep, voffB); PG8_STAGE(PG8_SA(1, 0), cA + kstep, voffA); PG8_STAGE(PG8_SB(1, 1), cB + hstepB + kstep, voffB);
        PG8_WAIT_V(6); PG8_BAR;
    } else {
        PG8_STAGE(PG8_SB(0, 0), cB, voffB); PG8_STAGE(PG8_SA(0, 0), cA, voffA); PG8_STAGE(PG8_SB(0, 1), cB + hstepB, voffB); PG8_STAGE(PG8_SA(0, 1), cA + hstepA, voffA);
        if (wr == 1) PG8_BAR;
        PG8_WAIT_V(4); PG8_BAR;
        PG8_STAGE(PG8_SB(1, 0), cB + kstep, voffB); PG8_STAGE(PG8_SA(1, 0), cA + kstep, voffA); PG8_STAGE(PG8_SB(1, 1), cB + hstepB + kstep, voffB);
        PG8_WAIT_V(6); PG8_BAR;
    }
    for (;;) {
        const bool has_next = S.next(ui + 1, nxt);
        const char* nA = has_next ? (const char*)g.A + (size_t)nxt.pm * tstepA : cA; const char* nB = has_next ? (const char*)g.Bt + (size_t)nxt.pn * tstepB : cB;
        for (int t = 0; t < nt; t += 2) {
            const bool last = (t == nt - 2);
            const char* a1 = cA + (size_t)(t + 1) * kstep;
            const char* a2 = last ? nA : cA + (size_t)(t + 2) * kstep; const char* b2 = last ? nB : cB + (size_t)(t + 2) * kstep;
            const char* a3 = a2 + kstep; const char* b3 = b2 + kstep;
            if (last && has_next) S.a_ready(nxt);
            if constexpr (SP2) {
            PG8_LDB(B0, 0, 0); PG8_LDB(B1, 0, 1); PG8_SCHED; PG8_LDA(At, 0, 0); PG8_STAGE(PG8_SA(1, 1), a1 + hstepA, voffA);
            PG8_WAIT_V(8); PG8_WAIT_L(0); PG8_BAR; PG8_MMA(0, 0, At, B0); PG8_MMA(0, 1, At, B1); PG8_BAR; PG8_SCHED;
            PG8_LDA(At, 0, 1); PG8_STAGE(PG8_SB(0, 0), b2, voffB); PG8_STAGE(PG8_SB(0, 1), b2 + hstepB, voffB); PG8_STAGE(PG8_SA(0, 0), a2, voffA);
            PG8_WAIT_V(8); PG8_WAIT_L(0); PG8_BAR; PG8_MMA(1, 0, At, B0); PG8_MMA(1, 1, At, B1); PG8_BAR; PG8_SCHED;
            PG8_LDB(B0, 1, 0); PG8_LDB(B1, 1, 1); PG8_SCHED; PG8_LDA(At, 1, 0); PG8_STAGE(PG8_SA(0, 1), a2 + hstepA, voffA);
            PG8_WAIT_V(8); PG8_WAIT_L(0); PG8_BAR; PG8_MMA(0, 0, At, B0); PG8_MMA(0, 1, At, B1); PG8_BAR; PG8_SCHED;
            PG8_LDA(At, 1, 1); PG8_STAGE(PG8_SB(1, 0), b3, voffB); PG8_STAGE(PG8_SB(1, 1), b3 + hstepB, voffB); PG8_STAGE(PG8_SA(1, 0), a3, voffA);
            PG8_WAIT_V(8); PG8_WAIT_L(0); PG8_BAR; PG8_MMA(1, 0, At, B0); PG8_MMA(1, 1, At, B1); PG8_BAR; PG8_SCHED;
            } else {
            PG8_LDB(B0, 0, 0); PG8_SCHED; PG8_LDA(At, 0, 0); PG8_STAGE(PG8_SA(1, 1), a1 + hstepA, voffA);
            PG8_WAIT_L(8); PG8_BAR; PG8_WAIT_L(0); PG8_MMA(0, 0, At, B0); PG8_BAR; PG8_SCHED;
            PG8_LDB(B1, 0, 1); PG8_STAGE(PG8_SB(0, 0), b2, voffB);
            PG8_BAR; PG8_WAIT_L(0); PG8_MMA(0, 1, At, B1); PG8_BAR;
            PG8_LDA(At, 0, 1); PG8_STAGE(PG8_SA(0, 0), a2, voffA);
            PG8_BAR; PG8_WAIT_L(0); PG8_MMA(1, 0, At, B0); PG8_BAR; PG8_SCHED;
            PG8_STAGE(PG8_SB(0, 1), b2 + hstepB, voffB);
            PG8_WAIT_V(6); PG8_BAR; PG8_MMA(1, 1, At, B1); PG8_BAR;
            PG8_LDB(B0, 1, 0); PG8_SCHED; PG8_LDA(At, 1, 0); PG8_STAGE(PG8_SA(0, 1), a2 + hstepA, voffA);
            PG8_WAIT_L(8); PG8_BAR; PG8_WAIT_L(0); PG8_MMA(0, 0, At, B0); PG8_BAR; PG8_SCHED;
            PG8_LDB(B1, 1, 1); PG8_STAGE(PG8_SB(1, 0), b3, voffB);
            PG8_BAR; PG8_WAIT_L(0); PG8_MMA(0, 1, At, B1); PG8_BAR;
            PG8_LDA(At, 1, 1); PG8_STAGE(PG8_SA(1, 0), a3, voffA);
            PG8_BAR; PG8_WAIT_L(0); PG8_MMA(1, 0, At, B0); PG8_BAR; PG8_SCHED;
            PG8_STAGE(PG8_SB(1, 1), b3 + hstepB, voffB);
            PG8_WAIT_V(6); PG8_BAR; PG8_MMA(1, 1, At, B1); PG8_BAR;
            }
        }
        if constexpr (ALIGN_EPI) { if (wr == 0) PG8_BAR; }
        if constexpr (!Epi::AFTER_DRAIN) { E(acc, cur, wr, wc, fr, fq); S.done(cur); }
        if (!has_next) break;
#pragma unroll
        for (int a = 0; a < 2; ++a)
#pragma unroll
            for (int b = 0; b < 2; ++b)
#pragma unroll
                for (int m = 0; m < 4; ++m)
#pragma unroll
                    for (int n = 0; n < 2; ++n) acc[a][b][m][n] = (f32x4){0.f, 0.f, 0.f, 0.f};
        cur = nxt; cA = nA; cB = nB; ++ui;
        if constexpr (ALIGN_EPI) { if (wr == 1) PG8_BAR; }
    }
    PG8_WAIT_V(0);
    if constexpr (!ALIGN_EPI) { if (wr == 0) PG8_BAR; }
    PG8_BAR;
#undef PG8_SA
#undef PG8_SB
#undef PG8_STAGE
#undef PG8_LDA
#undef PG8_LDB
#undef PG8_MMA
#undef PG8_WAIT_V
#undef PG8_WAIT_L
#undef PG8_BAR
#undef PG8_SCHED
}
}

__device__ __forceinline__ void p0_transpose_item(const float* W, int N, bf16* WT, int ldo, int drow0, LAS float* scr, int kb, int nb, int lane, const float* mu, int mode) {
    const int k0 = 64 * kb, n0 = 32 * nb;
    float wv[32];
#pragma unroll
    for (int i = 0; i < 32; ++i) wv[i] = __builtin_nontemporal_load(W + (size_t)(k0 + 2 * i + (lane >> 5)) * N + n0 + (lane & 31));
#pragma unroll
    for (int i = 0; i < 32; ++i) { const int kk = 2 * i + (lane >> 5); float v = wv[i];
        if (mode) { const float m = mu[k0 + kk]; v *= (mode == 1) ? (1.0f - m) : m; }
        scr[kk * 33 + (lane & 31)] = v; }
    asm volatile("s_waitcnt lgkmcnt(0)" ::: "memory");
    const int c = lane & 7;
#pragma unroll
    for (int j = 0; j < 4; ++j) { const int n = (lane >> 3) + 8 * j; const LAS float* s = scr + (8 * c) * 33 + n;
        u32x4 o; o.x = pk2(s[0 * 33], s[1 * 33]); o.y = pk2(s[2 * 33], s[3 * 33]); o.z = pk2(s[4 * 33], s[5 * 33]); o.w = pk2(s[6 * 33], s[7 * 33]);
        *(u32x4*)(WT + (size_t)(drow0 + n) * ldo + k0 + 8 * c) = o; }
    asm volatile("s_waitcnt lgkmcnt(0)" ::: "memory");
}
__device__ __forceinline__ void modnorm_row2(const float* xrow, bf16* orow, const float* gain, const float* sc, const float* sh, int lane) {
    const f32x4* xr = (const f32x4*)xrow + lane;
    f32x4 v[2][8]; float s0 = 0.f, s1 = 0.f;
#pragma unroll
    for (int j = 0; j < 8; ++j) { v[0][j] = __builtin_nontemporal_load(xr + 64 * j); v[1][j] = __builtin_nontemporal_load(xr + 512 + 64 * j); }
#pragma unroll
    for (int j = 0; j < 8; ++j) { s0 += (v[0][j][0] * v[0][j][0] + v[0][j][1] * v[0][j][1]) + (v[0][j][2] * v[0][j][2] + v[0][j][3] * v[0][j][3]);
                                  s1 += (v[1][j][0] * v[1][j][0] + v[1][j][1] * v[1][j][1]) + (v[1][j][2] * v[1][j][2] + v[1][j][3] * v[1][j][3]); }
    const float r0 = __builtin_amdgcn_rsqf(wave_sum(s0) * (1.0f / DM) + 1e-6f), r1 = __builtin_amdgcn_rsqf(wave_sum(s1) * (1.0f / DM) + 1e-6f);
    u32x2* o8 = (u32x2*)orow + lane;
#pragma unroll
    for (int j = 0; j < 8; ++j) { const f32x4 gm = ((const f32x4*)gain)[lane + 64 * j] * (((const f32x4*)sc)[lane + 64 * j] + 1.0f), b = ((const f32x4*)sh)[lane + 64 * j];
        o8[64 * j] = pk4(v[0][j] * r0 * gm + b); o8[512 + 64 * j] = pk4(v[1][j] * r1 * gm + b); }
}

__device__ __forceinline__ void late_weight_copies(const float* w_out, const float* w_gu, const float* w_dn, bf16* WOT, bf16* WGUT, bf16* WDT, LAS float* scr, int lane, int first, int stride) {
    constexpr int I_O = 32 * 64, I_GU = 32 * 352, I_DN = 88 * 64;
    for (int it = first; it < I_O + I_GU + I_DN; it += stride) { int r = it;
        if (r < I_O) { p0_transpose_item(w_out, DM, WOT, DM, 32 * (r % 64), scr, r / 64, r % 64, lane, nullptr, 0); continue; } r -= I_O;
        if (r < I_GU) { const int nb = r % 352, n0 = 32 * nb; const int drow = (n0 < DFF) ? ((n0 / 128) * 256 + n0 % 128) : (((n0 - DFF) / 128) * 256 + 128 + (n0 - DFF) % 128);
            p0_transpose_item(w_gu, 2 * DFF, WGUT, DM, drow, scr, r / 352, nb, lane, nullptr, 0); continue; }
        r -= I_GU;
        p0_transpose_item(w_dn, DM, WDT, DFF, 32 * (r % 64), scr, r / 64, r % 64, lane, nullptr, 0); }
}

__device__ __forceinline__ void sh2_gemv(const float* mod, const float* w_gu, float* c2, int first, int stride) {
    for (int it = first; it < 32 * 2816; it += stride) { const int kc = it / 2816, n4 = it % 2816;
        f32x4 a0 = {0.f, 0.f, 0.f, 0.f}, a1 = a0, a2 = a0, a3 = a0;
        for (int k0 = 64 * kc; k0 < 64 * kc + 64; k0 += 8) { f32x4 wv[8];
#pragma unroll
            for (int u = 0; u < 8; ++u) wv[u] = *(const f32x4*)(w_gu + (size_t)(k0 + u) * (2 * DFF) + 4 * n4);
#pragma unroll
            for (int u = 0; u < 8; ++u) { const float* sp = mod + 3 * DM + k0 + u; a0 += wv[u] * sp[0]; a1 += wv[u] * sp[NMOD]; a2 += wv[u] * sp[2 * NMOD]; a3 += wv[u] * sp[3 * NMOD]; } }
#pragma unroll
        for (int j = 0; j < 4; ++j) { atomicAdd(c2 + 4 * n4 + j, a0[j]); atomicAdd(c2 + 2 * DFF + 4 * n4 + j, a1[j]); atomicAdd(c2 + 4 * DFF + 4 * n4 + j, a2[j]); atomicAdd(c2 + 6 * DFF + 4 * n4 + j, a3[j]); } }
}

struct PrepPtrs { const bf16* PRKV; bf16* L2O; bf16* SR; bf16* SKT; bf16* SWR; bf16* SREM; bf16* SV; float* BS; const float* mu; const float* pw0; const float* pa0; const float* pkk; const float* pka; const float* prk; };
__device__ __forceinline__ void rwkv_prep(const PrepPtrs& P, int wv, int nwv, int lane, int sel) {
    const bf16* PRKV = P.PRKV; bf16* L2O = P.L2O; bf16* SR = P.SR; bf16* SKT = P.SKT; bf16* SWR = P.SWR; bf16* SREM = P.SREM; bf16* SV = P.SV; float* BS = P.BS;
    const float* mu = P.mu; const float* pw0 = P.pw0; const float* pa0 = P.pa0; const float* pkk = P.pkk; const float* pka = P.pka; const float* prk = P.prk;
    { const int q4 = wv & 3, c = 256 * q4 + 4 * lane, head = 4 * q4 + (lane >> 4);
          const f32x4 mur = *(const f32x4*)(mu + c), muk = *(const f32x4*)(mu + DR + c), muv = *(const f32x4*)(mu + 2 * DR + c);
          const f32x4 w0 = *(const f32x4*)(pw0 + c), a0 = *(const f32x4*)(pa0 + c), kkc = *(const f32x4*)(pkk + c), kac = *(const f32x4*)(pka + c), rkc = *(const f32x4*)(prk + c);
          const int per = (sel == 0) ? SEQ / 16 : (sel == 1) ? 3 * SEQ / 16 : SEQ / 4, goff = (sel == 1) ? SEQ / 16 : 0;
          for (int qi = wv >> 2; qi < BATCH * per; qi += nwv >> 2) { const int tg = (qi / per) * (SEQ / 4) + goff + (qi % per);
              const int t0 = 4 * tg; const bool first = (t0 & (SEQ - 1)) == 0;
              const bf16* pc = PRKV + (size_t)t0 * 3072 + c; const u32x2 z2 = {0u, 0u};
              u32x2 rr[5], rk[5], rv[5], lxw[4], lxa[4];
              if (!first) { rr[0] = *(const u32x2*)(pc - 3072); rk[0] = *(const u32x2*)(pc - 3072 + DR); rv[0] = *(const u32x2*)(pc - 3072 + 2 * DR); } else { rr[0] = z2; rk[0] = z2; rv[0] = z2; }
#pragma unroll
              for (int i = 0; i < 4; ++i) { rr[i + 1] = *(const u32x2*)(pc + (size_t)i * 3072); rk[i + 1] = *(const u32x2*)(pc + (size_t)i * 3072 + DR); rv[i + 1] = *(const u32x2*)(pc + (size_t)i * 3072 + 2 * DR);
                  lxw[i] = *(const u32x2*)(L2O + (size_t)(t0 + i) * 3072 + c); lxa[i] = *(const u32x2*)(L2O + (size_t)(t0 + i) * 3072 + DR + c); }
#pragma unroll
              for (int i = 0; i < 4; ++i) {
                  const f32x4 pr = bf4(rr[i + 1]), pk = bf4(rk[i + 1]), pv = bf4(rv[i + 1]);
                  const f32x4 r = pr + (bf4(rr[i]) - pr) * mur, k = pk + (bf4(rk[i]) - pk) * muk, v = pv + (bf4(rv[i]) - pv) * muv;
                  const f32x4 xw = bf4(lxw[i]), xa = bf4(lxa[i]);
                  f32x4 a, d1;
#pragma unroll
                  for (int j = 0; j < 4; ++j) { a[j] = sigmoidf_(a0[j] + xa[j]); d1[j] = 1.0f - fexp2(-0.6065306597126334f * LOG2E * sigmoidf_(w0[j] + xw[j])); }
                  typedef _Float16 h4 __attribute__((ext_vector_type(4)));
                  const h4 dh = {(_Float16)d1[0], (_Float16)d1[1], (_Float16)d1[2], (_Float16)d1[3]};
                  f32x4 kk = k * kkc; const float ss = allsum16((kk[0] * kk[0] + kk[1] * kk[1]) + (kk[2] * kk[2] + kk[3] * kk[3])); kk = kk * __builtin_amdgcn_rsqf(ss + 1e-12f);
                  const f32x4 kt = k * ((a - 1.0f) * kac + 1.0f), pcv = r * kt * rkc;
                  const float bs = allsum16((pcv[0] + pcv[1]) + (pcv[2] + pcv[3]));
                  const size_t off = (size_t)(t0 + i) * DR + c;
                  *(u32x2*)(SR + off) = pk4(r); *(u32x2*)(SKT + off) = pk4(kt); *(u32x2*)(SWR + off) = pk4(kk * a); *(u32x2*)(SREM + off) = pk4(-kk); *(u32x2*)(SV + off) = pk4(v);
                  *(u32x2*)(L2O + (size_t)(t0 + i) * 3072 + c) = __builtin_bit_cast(u32x2, dh);
                  if ((lane & 15) == 0) BS[(size_t)(t0 + i) * 16 + head] = bs; } } }
}

constexpr int SB_KP = 72, SB_VP = 68;
__device__ __forceinline__ u32x4 sb_knorm(u32x4 raw, const f32x4& g0, const f32x4& g1) {
    const f32x4 a = bf4((u32x2){raw.x, raw.y}), b = bf4((u32x2){raw.z, raw.w});
    float ss = ((a[0] * a[0] + a[1] * a[1]) + (a[2] * a[2] + a[3] * a[3])) + ((b[0] * b[0] + b[1] * b[1]) + (b[2] * b[2] + b[3] * b[3]));
    ss += dppf<0xB1>(ss); ss += dppf<0x4E>(ss); ss += dppf<0x141>(ss);
    const float rs = __builtin_amdgcn_rsqf(ss * (1.0f / 64.0f) + 1e-6f);
    const f32x4 x = a * rs * g0, y = b * rs * g1; const u32x2 p = pk4(x), q = pk4(y);
    return (u32x4){p.x, p.y, q.x, q.y};
}
__device__ __forceinline__ void sb_attn_unit(LAS unsigned char* lds, const bf16* PSB, bf16* YC, const float* gq, const float* gk, int b, int h, int qb) {
    const int tid = threadIdx.x, lane = tid & 63, r32 = lane & 31, hi = lane >> 5; const int wid = __builtin_amdgcn_readfirstlane(tid >> 6);
    LAS bf16* Ks = (LAS bf16*)lds; LAS bf16* Vt = (LAS bf16*)(lds + 64 * SB_KP * 2);
    const int q0 = qb * 256; const size_t rowbase = (size_t)b * SEQ;
    const bf16* Qw = PSB + (rowbase + q0 + wid * 32 + r32) * 3072 + h * 64;
    bf16x8 qr[4];
    { u32x4 qraw[4]; float ss = 0.f;
#pragma unroll
      for (int d0 = 0; d0 < 4; ++d0) { qraw[d0] = *(const u32x4*)(Qw + d0 * 16 + hi * 8); const f32x4 a = bf4((u32x2){qraw[d0].x, qraw[d0].y}), c = bf4((u32x2){qraw[d0].z, qraw[d0].w});
          ss += ((a[0] * a[0] + a[1] * a[1]) + (a[2] * a[2] + a[3] * a[3])) + ((c[0] * c[0] + c[1] * c[1]) + (c[2] * c[2] + c[3] * c[3])); }
      ss += __shfl_xor(ss, 32);
      const float rs = __builtin_amdgcn_rsqf(ss * (1.0f / 64.0f) + 1e-6f) * (0.125f * LOG2E);
#pragma unroll
      for (int d0 = 0; d0 < 4; ++d0) { const f32x4 g0 = *(const f32x4*)(gq + d0 * 16 + hi * 8), g1 = *(const f32x4*)(gq + d0 * 16 + hi * 8 + 4);
          const f32x4 a = bf4((u32x2){qraw[d0].x, qraw[d0].y}) * rs * g0, c = bf4((u32x2){qraw[d0].z, qraw[d0].w}) * rs * g1; const u32x2 p = pk4(a), q = pk4(c);
          qr[d0] = __builtin_bit_cast(bf16x8, (u32x4){p.x, p.y, q.x, q.y}); } }
    half8 L0, L1, ones;
#pragma unroll
    for (int j = 0; j < 8; ++j) { const int kv = 4 * hi + (j & 3) + 8 * (j >> 2); L0[j] = (kv > r32) ? (_Float16)1.0f : (_Float16)0.0f; L1[j] = (kv + 16 > r32) ? (_Float16)1.0f : (_Float16)0.0f; ones[j] = (_Float16)1.0f; }
    f32x16 o[2]; o[0] = f32x16{}; o[1] = f32x16{};
    float R = 0.f; bool done = false;
    const int ldrow = tid >> 3, ch = tid & 7;
    const f32x4 gk0 = *(const f32x4*)(gk + 8 * ch), gk1 = *(const f32x4*)(gk + 8 * ch + 4);
    const bf16* kvsrc = PSB + (rowbase + ldrow) * 3072 + h * 64 + 8 * ch;
    int jt = 4 * qb + 3;
    u32x4 kreg = *(const u32x4*)(kvsrc + (size_t)(64 * jt) * 3072 + 1024), vreg = *(const u32x4*)(kvsrc + (size_t)(64 * jt) * 3072 + 2048);
    const int qabs = q0 + wid * 32 + r32;
    for (; jt >= 0; --jt) {
        *(LAS u32x4*)(Ks + ldrow * SB_KP + 8 * ch) = sb_knorm(kreg, gk0, gk1);
        { const unsigned w[4] = {vreg.x, vreg.y, vreg.z, vreg.w};
#pragma unroll
          for (int j = 0; j < 4; ++j) { Vt[(8 * ch + 2 * j) * SB_VP + ldrow] = (bf16)(w[j] & 0xffffu); Vt[(8 * ch + 2 * j + 1) * SB_VP + ldrow] = (bf16)(w[j] >> 16); } }
        __syncthreads();
        if (jt > 0) { kreg = *(const u32x4*)(kvsrc + (size_t)(64 * (jt - 1)) * 3072 + 1024); vreg = *(const u32x4*)(kvsrc + (size_t)(64 * (jt - 1)) * 3072 + 2048); }
        const bool active = !done && (64 * jt < q0 + 32 * wid + 31);
        if (active) {
            f32x16 p[2];
#pragma unroll
            for (int mb = 0; mb < 2; ++mb) { f32x16 a = f32x16{};
#pragma unroll
                for (int d0 = 0; d0 < 4; ++d0) { const bf16x8 kf = *(const LAS bf16x8*)(Ks + (32 * mb + r32) * SB_KP + 16 * d0 + 8 * hi); a = __builtin_amdgcn_mfma_f32_32x32x16_bf16(kf, qr[d0], a, 0, 0, 0); }
                p[mb] = a; }
            const bool diag = (64 * jt + 63 >= q0 + 32 * wid);
            const int kvb = 64 * jt + 4 * hi;
            float sp[2][16];
#pragma unroll
            for (int mb = 0; mb < 2; ++mb)
#pragma unroll
                for (int r = 0; r < 16; ++r) { const int kv = kvb + (r & 3) + 8 * (r >> 2) + 32 * mb; float s = flog2(1.0f + fexp2(p[mb][r])); if (diag && kv >= qabs) s = 0.f; sp[mb][r] = s; }
            half8 spf[4];
#pragma unroll
            for (int s = 0; s < 4; ++s)
#pragma unroll
                for (int j = 0; j < 8; ++j) spf[s][j] = (_Float16)sp[s >> 1][8 * (s & 1) + j];
            f32x16 T0 = f32x16{}, T1 = f32x16{};
            T0 = __builtin_amdgcn_mfma_f32_32x32x16_f16(L0, spf[0], T0, 0, 0, 0); T0 = __builtin_amdgcn_mfma_f32_32x32x16_f16(L1, spf[1], T0, 0, 0, 0);
            T0 = __builtin_amdgcn_mfma_f32_32x32x16_f16(ones, spf[2], T0, 0, 0, 0); T0 = __builtin_amdgcn_mfma_f32_32x32x16_f16(ones, spf[3], T0, 0, 0, 0);
            T1 = __builtin_amdgcn_mfma_f32_32x32x16_f16(L0, spf[2], T1, 0, 0, 0); T1 = __builtin_amdgcn_mfma_f32_32x32x16_f16(L1, spf[3], T1, 0, 0, 0);
            float tot = T0[0] + sp[0][0];
            tot = __shfl(tot, r32);
            float av[2][16];
#pragma unroll
            for (int r = 0; r < 16; ++r) { const int kv = kvb + (r & 3) + 8 * (r >> 2);
                float a0 = fexp2(p[0][r] - sp[0][r] - T0[r] - R), a1 = fexp2(p[1][r] - sp[1][r] - T1[r] - R);
                if (diag && kv >= qabs) a0 = 0.f; if (diag && kv + 32 >= qabs) a1 = 0.f; av[0][r] = a0; av[1][r] = a1; }
            bf16x8 pa[4];
#pragma unroll
            for (int s = 0; s < 4; ++s) { u32x4 w;
                w.x = pk2(av[s >> 1][8 * (s & 1) + 0], av[s >> 1][8 * (s & 1) + 1]); w.y = pk2(av[s >> 1][8 * (s & 1) + 2], av[s >> 1][8 * (s & 1) + 3]);
                w.z = pk2(av[s >> 1][8 * (s & 1) + 4], av[s >> 1][8 * (s & 1) + 5]); w.w = pk2(av[s >> 1][8 * (s & 1) + 6], av[s >> 1][8 * (s & 1) + 7]);
                pa[s] = __builtin_bit_cast(bf16x8, w); }
#pragma unroll
            for (int nb = 0; nb < 2; ++nb)
#pragma unroll
                for (int s = 0; s < 4; ++s) { const LAS bf16* vp = Vt + (r32 + 32 * nb) * SB_VP + 16 * s + 4 * hi;
                    const u32x2 lo = *(const LAS u32x2*)vp, hi2 = *(const LAS u32x2*)(vp + 8);
                    const u32x4 vv = {lo.x, lo.y, hi2.x, hi2.y};
                    o[nb] = __builtin_amdgcn_mfma_f32_32x32x16_bf16(pa[s], __builtin_bit_cast(bf16x8, vv), o[nb], 0, 0, 0); }
            R += tot;
            if (__all(R > 151.0f)) done = true;
        }
        if (__syncthreads_and(done ? 1 : 0)) break;
    }
    bf16* Ow = YC + (rowbase + q0 + wid * 32) * 2048 + 1024 + h * 64;
#pragma unroll
    for (int r = 0; r < 16; ++r) { const int q = (r & 3) + 8 * (r >> 2) + 4 * hi;
#pragma unroll
        for (int nb = 0; nb < 2; ++nb) Ow[(size_t)q * 2048 + r32 + 32 * nb] = (bf16)f2bf(o[nb][r]); }
}

constexpr int SC_TC = 16, SC_REC = 352;
constexpr int SC_INB = SC_TC * SC_REC;
constexpr int SC_YB = SC_TC * 512;
struct ScanRegs { u32x2 r, k, wr, m, d, v; };
struct ScanPtrs { const bf16* SR; const bf16* SKT; const bf16* SWR; const bf16* SREM; const bf16* SV; const bf16* L2O; };
__device__ __forceinline__ void scan_item(LAS unsigned char* lds, const ScanPtrs& P, bf16* YC, int item, unsigned* half_cnt, unsigned half_expect) {
    const int tid = threadIdx.x, lane = tid & 63; const int wid = __builtin_amdgcn_readfirstlane(tid >> 6);
    const int bh = item >> 1, half = item & 1, b = bh >> 4, h = bh & 15;
    LAS float* inb = (LAS float*)lds;
    LAS float* ypb = inb + 2 * SC_INB;
    const size_t tok0 = (size_t)b * SEQ;
    constexpr int NCH = SEQ / SC_TC;
    if (wid >= 4) {
        const int ltid = tid - 256, tk = ltid >> 4, cgp = ltid & 15;
        const bool isv = (cgp >> 3) == half;
        const size_t offA = (tok0 + tk) * DR + h * 64 + 4 * cgp;
        const bf16* lbase = P.L2O + (tok0 + tk) * 3072 + h * 64 + 4 * cgp;
        bf16* yout0 = YC + (tok0 + (ltid >> 5)) * 2048 + h * 64 + 32 * half + (ltid & 31);
        const int yrot = ((ltid & 31) >> 2) & 3;
        ScanRegs q0, q1;
#define SC_LOAD(Q, c) do { const size_t o_ = offA + (size_t)(c) * SC_TC * DR; (Q).r = *(const u32x2*)(P.SR + o_); (Q).k = *(const u32x2*)(P.SKT + o_); (Q).wr = *(const u32x2*)(P.SWR + o_); \
        (Q).m = *(const u32x2*)(P.SREM + o_); (Q).d = *(const u32x2*)(lbase + (size_t)(c) * SC_TC * 3072); if (isv) (Q).v = *(const u32x2*)(P.SV + o_); } while (0)
#define SC_STORE(Q, bi) do { LAS float* rec = inb + (bi) * SC_INB + tk * SC_REC + 4 * cgp; typedef _Float16 h4_ __attribute__((ext_vector_type(4))); const h4_ dh_ = __builtin_bit_cast(h4_, (Q).d); \
        *(LAS f32x4*)(rec) = (f32x4){1.0f - (float)dh_[0], 1.0f - (float)dh_[1], 1.0f - (float)dh_[2], 1.0f - (float)dh_[3]}; \
        *(LAS f32x4*)(rec + 64) = bf4((Q).m); *(LAS f32x4*)(rec + 128) = bf4((Q).wr); *(LAS f32x4*)(rec + 192) = bf4((Q).k); *(LAS f32x4*)(rec + 256) = bf4((Q).r); \
        if (isv) *(LAS f32x4*)(inb + (bi) * SC_INB + tk * SC_REC + 320 + 4 * (cgp & 7)) = bf4((Q).v); } while (0)
#define SC_YRED(bi, c) do { _Pragma("unroll") for (int hh = 0; hh < 2; ++hh) { const LAS f32x4* yp_ = (const LAS f32x4*)(ypb + (bi) * SC_YB + (ltid + 256 * hh) * 16); \
        const f32x4 a_ = yp_[yrot], b_ = yp_[(yrot + 1) & 3], c_ = yp_[(yrot + 2) & 3], d_ = yp_[(yrot + 3) & 3]; const f32x4 s_ = (a_ + b_) + (c_ + d_); \
        yout0[((size_t)(c) * SC_TC + 8 * hh) * 2048] = (bf16)f2bf((s_[0] + s_[1]) + (s_[2] + s_[3])); } } while (0)
        SC_LOAD(q0, 0); SC_LOAD(q1, 1); SC_STORE(q0, 0); SC_LOAD(q0, 2);
        __syncthreads();
        for (int c = 0; c < NCH; c += 2) {
            if (c == NCH / 4 - 8) {
                unsigned sp_ = 0u; while (xb_ld(half_cnt) < half_expect) { __builtin_amdgcn_s_sleep(8); if (++sp_ > (1u << 20)) break; }
                __builtin_amdgcn_fence(__ATOMIC_ACQUIRE, "agent"); asm volatile("s_waitcnt vmcnt(0)" ::: "memory"); }
            SC_STORE(q1, 1); if (c + 3 < NCH) SC_LOAD(q1, c + 3);
            if (c > 0) SC_YRED(1, c - 1);
            __syncthreads();
            if (c + 2 < NCH) SC_STORE(q0, 0); if (c + 4 < NCH) SC_LOAD(q0, c + 4);
            SC_YRED(0, c);
            __syncthreads();
        }
        SC_YRED(1, NCH - 1);
#undef SC_LOAD
#undef SC_STORE
#undef SC_YRED
    } else {
        const int g = lane & 15, ra = 8 * wid + (lane >> 4);
        f32x2 A01 = {0.f, 0.f}, A23 = {0.f, 0.f}, B01 = {0.f, 0.f}, B23 = {0.f, 0.f};
        __builtin_amdgcn_s_setprio(3);
        __syncthreads();
        for (int c = 0; c < NCH; ++c) {
            const LAS float* Bk = inb + (c & 1) * SC_INB + 4 * g;
            const LAS float* Bv = inb + (c & 1) * SC_INB + 320 + ra;
            LAS float* Y = ypb + (c & 1) * SC_YB + ra * 16 + g;
            f32x4 cw, cm, cwr, ck, cr, nw, nm, nwr, nk, nr; float cva, cvb, nva, nvb;
#define SC_RD(s, W, Mm, WR, Kk, Rr, Va, Vb) do { W = *(const LAS f32x4*)(Bk + (s) * SC_REC); Mm = *(const LAS f32x4*)(Bk + (s) * SC_REC + 64); WR = *(const LAS f32x4*)(Bk + (s) * SC_REC + 128); \
                Kk = *(const LAS f32x4*)(Bk + (s) * SC_REC + 192); Rr = *(const LAS f32x4*)(Bk + (s) * SC_REC + 256); Va = Bv[(s) * SC_REC]; Vb = Bv[(s) * SC_REC + 4]; } while (0)
            SC_RD(0, cw, cm, cwr, ck, cr, cva, cvb);
#pragma unroll
            for (int s = 0; s < SC_TC; ++s) {
                if (s + 1 < SC_TC) SC_RD(s + 1, nw, nm, nwr, nk, nr, nva, nvb);
                __builtin_amdgcn_sched_barrier(0);
                const f32x2 m01 = {cm[0], cm[1]}, m23 = {cm[2], cm[3]}, w01 = {cw[0], cw[1]}, w23 = {cw[2], cw[3]}, wr01 = {cwr[0], cwr[1]}, wr23 = {cwr[2], cwr[3]},
                            k01 = {ck[0], ck[1]}, k23 = {ck[2], ck[3]}, r01 = {cr[0], cr[1]}, r23 = {cr[2], cr[3]};
                f32x2 qa = A01 * m01; qa = __builtin_elementwise_fma(A23, m23, qa);
                f32x2 qb = B01 * m01; qb = __builtin_elementwise_fma(B23, m23, qb);
                float da = qa[0] + qa[1], db = qb[0] + qb[1];
                const f32x2 vka01 = k01 * cva, vka23 = k23 * cva, vkb01 = k01 * cvb, vkb23 = k23 * cvb;
                da += dppf<0xB1>(da);  db += dppf<0xB1>(db);
                da += dppf<0x4E>(da);  db += dppf<0x4E>(db);
                da += dppf<0x141>(da); db += dppf<0x141>(db);
                da += dppf<0x140>(da); db += dppf<0x140>(db);
                const f32x2 sa2 = {da, da}, sb2 = {db, db};
                A01 = __builtin_elementwise_fma(A01, w01, __builtin_elementwise_fma(wr01, sa2, vka01)); A23 = __builtin_elementwise_fma(A23, w23, __builtin_elementwise_fma(wr23, sa2, vka23));
                B01 = __builtin_elementwise_fma(B01, w01, __builtin_elementwise_fma(wr01, sb2, vkb01)); B23 = __builtin_elementwise_fma(B23, w23, __builtin_elementwise_fma(wr23, sb2, vkb23));
                f32x2 ya = A01 * r01; ya = __builtin_elementwise_fma(A23, r23, ya);
                f32x2 yb = B01 * r01; yb = __builtin_elementwise_fma(B23, r23, yb);
                Y[s * 512] = ya[0] + ya[1]; Y[s * 512 + 64] = yb[0] + yb[1];
                __builtin_amdgcn_sched_barrier(0);
                cw = nw; cm = nm; cwr = nwr; ck = nk; cr = nr; cva = nva; cvb = nvb;
            }
#undef SC_RD
            __syncthreads();
        }
        __builtin_amdgcn_s_setprio(0);
    }
}

#define XB_TMO      128
#define XB_XCNT(j)  (256  + 64 * (j))
#define XB_XSUB(j)  (1280 + 64 * (j))
#define XB_XGEN(j)  (2304 + 64 * (j))
#define XB_TOP      3328
#define XB_TOPGEN   3392
#define XCD_BAR_WORDS 3456
#define XB_SPIN_CAP (1u << 18)
__device__ __forceinline__ unsigned xb_xcc_id() { return (unsigned)__builtin_amdgcn_s_getreg((3 << 11) | 20) & 0xFu; }
#define XB_SPIN(cond, bar) do { unsigned _sp = 0; while (cond) { __builtin_amdgcn_s_sleep(1); \
    if ((++_sp & 255u) == 0u) { if (xb_ld(&(bar)[XB_TMO])) break; if (_sp > XB_SPIN_CAP) { atomicAdd(&(bar)[XB_TMO], 1u); break; } } } } while (0)
struct XcdBarrier { unsigned* bar; unsigned x; volatile LAS unsigned* st; };
__device__ __forceinline__ XcdBarrier xcd_barrier_post(unsigned* bar, volatile LAS unsigned* st) {
    XcdBarrier b; b.bar = bar; b.x = xb_xcc_id(); b.st = st;
    if (threadIdx.x == 0) (void)xb_add(&bar[XB_XCNT(b.x)], 1u);
    return b;
}
__device__ __forceinline__ void xcd_barrier_complete(unsigned* bar, unsigned x, unsigned& nloc, unsigned& nx) {
    const unsigned G = gridDim.x * gridDim.y * gridDim.z;
    unsigned sum, cnt, mine, sp = 0u;
    for (;;) {
        sum = 0u; cnt = 0u; mine = 0u;
#pragma unroll
        for (unsigned j = 0; j < 16; ++j) { const unsigned c = xb_ld(&bar[XB_XCNT(j)]); sum += c; cnt += (c > 0u) ? 1u : 0u; mine = (j == x) ? c : mine; }
        if (sum == G) break;
        __builtin_amdgcn_s_sleep(1);
        if ((++sp & 255u) == 0u) { if (xb_ld(&bar[XB_TMO])) break; if (sp > XB_SPIN_CAP) { atomicAdd(&bar[XB_TMO], 1u); break; } }
    }
    nloc = mine > 0u ? mine : 1u; nx = cnt > 0u ? cnt : 1u;
}
__device__ __forceinline__ void xcd_barrier(const XcdBarrier& b) {
    asm volatile("s_waitcnt vmcnt(0)" ::: "memory");
    __syncthreads();
    if (threadIdx.x == 0) {
        unsigned* bar = b.bar;
        __builtin_amdgcn_s_waitcnt(0);
        unsigned nloc = b.st[0], nx = b.st[1];
        if (nloc == 0u) { xcd_barrier_complete(bar, b.x, nloc, nx); b.st[0] = nloc; b.st[1] = nx; }
        const unsigned old = xb_add(&bar[XB_XSUB(b.x)], 1u);
        const unsigned gen = old / nloc;
        if (old + 1u == (gen + 1u) * nloc) {
            __builtin_amdgcn_fence(__ATOMIC_RELEASE, "agent");
            asm volatile("s_waitcnt vmcnt(0)" ::: "memory");
            const unsigned og = xb_add(&bar[XB_TOP], 1u);
            const unsigned tg = og / nx;
            if (og + 1u == (tg + 1u) * nx) xb_add(&bar[XB_TOPGEN], 1u);
            else XB_SPIN(xb_ld(&bar[XB_TOPGEN]) == tg, bar);
            __builtin_amdgcn_fence(__ATOMIC_ACQUIRE, "agent");
            xb_add(&bar[XB_XGEN(b.x)], 1u);
            asm volatile("s_waitcnt vmcnt(0)" ::: "memory");
        } else {
            XB_SPIN(xb_ld(&bar[XB_XGEN(b.x)]) == gen, bar);
            __builtin_amdgcn_fence(__ATOMIC_ACQUIRE, "agent");
            asm volatile("s_waitcnt vmcnt(0)" ::: "memory");
        }
    }
    __syncthreads();
}

struct Args { const float* in[29]; float* out; unsigned char* ws; int ph_lo, ph_hi; };
constexpr int N_PHASES = 12;

__global__ void __launch_bounds__(512, 2) mk_fwd(Args args) {
    extern __shared__ __attribute__((aligned(16))) unsigned char lds_raw[];
    LAS unsigned char* lds = (LAS unsigned char*)lds_raw;
    cg::grid_group grid = cg::this_grid();
    const int wave = __builtin_amdgcn_readfirstlane(threadIdx.x >> 6);
    const int G = gridDim.x, NGW = G * 8, NGT = G * 512;
    unsigned char* ws = args.ws;
    const float* x = args.in[0]; float* out = args.out;
    float* mod = (float*)(ws + WS_CTL);
    bf16* W1T = (bf16*)(ws + WS_W1T); bf16* WOT = (bf16*)(ws + WS_WOT); bf16* WGUT = (bf16*)(ws + WS_WGUT); bf16* WDT = (bf16*)(ws + WS_WDT); bf16* W2T = (bf16*)(ws + WS_W2T);
    bf16* Hb = (bf16*)(ws + WS_H); bf16* PRKV = (bf16*)(ws + WS_PRKV); bf16* PSB = (bf16*)(ws + WS_PSB); bf16* PLORA = (bf16*)(ws + WS_PLORA);
    bf16* HID = (bf16*)(ws + WS_HID); bf16* L2O = (bf16*)(ws + WS_L2O); bf16* ACT = (bf16*)(ws + WS_ACT); bf16* YC = (bf16*)(ws + WS_YCAT);
    float* rowss = (float*)(ws + 256 * 1024); float* c2v = (float*)(ws + 320 * 1024);
    unsigned* hcnt = (unsigned*)(ws + WS_BAR) + 8192;
    bf16* H2 = (bf16*)(ws + WS_L2O);
    float* BS = (float*)(ws + WS_BS);
    bf16* SR = (bf16*)out; bf16* SKT = SR + SCAN_ARR; bf16* SWR = SKT + SCAN_ARR; bf16* SREM = SWR + SCAN_ARR;
    bf16* SV = (bf16*)(ws + WS_SV);
    const int lo = args.ph_lo, hi = args.ph_hi;
#define IN(k) (lo <= (k) && (k) < hi)
    volatile LAS unsigned* MISC = (volatile LAS unsigned*)(lds + 131072 + 64);
    if (threadIdx.x < 16) MISC[threadIdx.x] = 0u;
    __syncthreads();
    XcdBarrier xbar = xcd_barrier_post((unsigned*)(ws + WS_BAR), MISC);
    if (args.ph_lo < 0) grid.sync();
#define SEAM(k) do { if ((k) != 9 && IN(k) && IN((k) + 1)) xcd_barrier(xbar); } while (0)

    if (IN(0)) { PHASE_IDS();
        LAS float* scr = (LAS float*)(lds + wave * 16384);
        const float* w_in = args.in[6]; const float* mu_w = args.in[8]; const float* mu_a = args.in[9]; const float* mu_g = args.in[10];
        const float* w1 = args.in[12]; const float* a1 = args.in[15]; const float* g1 = args.in[17];
        const float* w_out = args.in[26]; const float* w_gu = args.in[27]; const float* w_dn = args.in[28];
        constexpr int I_IN = 32 * 192, I_L = 2 * (64 + 64 + 160);
        constexpr int NITEMS = I_IN + I_L;
        for (int rep = 0; rep < (PROBE == 3 ? 2 : 1); ++rep)
        for (int it = gw; it < NITEMS; it += NGW) {
            int r = it;
            if (r < I_IN) { p0_transpose_item(w_in, 6144, W1T, DM, 32 * (r % 192), scr, r / 192, r % 192, lane, nullptr, 0); continue; } r -= I_IN;
            { const int part = r / NLORA; int q = r % NLORA;
                const int rb = 6144 + part * NLORA;
                if (q < 64) { p0_transpose_item(w1, 64, W1T, DM, rb + 32 * (q % 2), scr, q / 2, q % 2, lane, mu_w, 1 + part); continue; } q -= 64;
                if (q < 64) { p0_transpose_item(a1, 64, W1T, DM, rb + 64 + 32 * (q % 2), scr, q / 2, q % 2, lane, mu_a, 1 + part); continue; } q -= 64;
                p0_transpose_item(g1, 160, W1T, DM, rb + 128 + 32 * (q % 5), scr, q / 5, q % 5, lane, mu_g, 1 + part); }
        }
        if (G < 256) late_weight_copies(w_out, w_gu, w_dn, WOT, WGUT, WDT, scr, lane, gw, NGW);
        for (int i = gtid; i < 192 * DM / 8; i += NGT) ((u32x4*)(W1T + (size_t)6720 * DM))[i] = (u32x4){0u, 0u, 0u, 0u};
        { const float* w2 = args.in[13]; const float* a2 = args.in[16]; const float* g2 = args.in[18];
          for (int i0 = gtid; i0 < 3072 * KH; i0 += 9 * NGT) { float v[9];
#pragma unroll
              for (int e = 0; e < 9; ++e) { const int i = i0 + e * NGT; v[e] = 0.f;
                  if (i < 3072 * KH) { const int row = i / KH, kk = i % KH, seg = row >> 10, c = row & 1023;
                      if (seg == 0) { if (kk < 64) v[e] = w2[kk * DR + c]; } else if (seg == 1) { if (kk >= 64 && kk < 128) v[e] = a2[(kk - 64) * DR + c]; } else { if (kk >= 128 && kk < 288) v[e] = g2[(kk - 128) * DR + c]; } } }
#pragma unroll
              for (int e = 0; e < 9; ++e) { const int i = i0 + e * NGT; if (i < 3072 * KH) W2T[i] = (bf16)f2bf(v[e]); } } }
        { const float* cvec = args.in[1]; const float* w_ada = args.in[2]; const float* b_ada = args.in[3];
          for (int it = gtid; it < 32 * 3072; it += NGT) { const int kc = it / 3072, n4 = it % 3072;
              f32x4 a0 = {0.f, 0.f, 0.f, 0.f}, a1v = a0, a2v = a0, a3v = a0;
              for (int k0 = 64 * kc; k0 < 64 * kc + 64; k0 += 16) { f32x4 wv[16];
#pragma unroll
                  for (int u = 0; u < 16; ++u) wv[u] = __builtin_nontemporal_load((const f32x4*)(w_ada + (size_t)(k0 + u) * NMOD + 4 * n4));
#pragma unroll
                  for (int u = 0; u < 16; ++u) { const int k = k0 + u; const float c0 = cvec[k], c1 = cvec[DM + k], c2 = cvec[2 * DM + k], c3 = cvec[3 * DM + k];
                      a0 += wv[u] * (c0 * sigmoidf_(c0)); a1v += wv[u] * (c1 * sigmoidf_(c1)); a2v += wv[u] * (c2 * sigmoidf_(c2)); a3v += wv[u] * (c3 * sigmoidf_(c3)); } }
              if (kc == 0) { const f32x4 bv = *(const f32x4*)(b_ada + 4 * n4); a0 += bv; a1v += bv; a2v += bv; a3v += bv; }
#pragma unroll
              for (int j = 0; j < 4; ++j) { atomicAdd(mod + 4 * n4 + j, a0[j]); atomicAdd(mod + NMOD + 4 * n4 + j, a1v[j]); atomicAdd(mod + 2 * NMOD + 4 * n4 + j, a2v[j]); atomicAdd(mod + 3 * NMOD + 4 * n4 + j, a3v[j]); } } }
    }
    SEAM(0);
    if (IN(1)) { PHASE_IDS(); const float* g1n = args.in[4];
        if (G < 256) sh2_gemv(mod, args.in[27], c2v, gtid, NGT);
        for (int m = 2 * gw; m < MTOK; m += 2 * NGW) { const float* mb = mod + (size_t)(m >> 12) * NMOD; modnorm_row2(x + (size_t)m * DM, Hb + (size_t)m * DM, g1n, mb + DM, mb, lane); } }
    SEAM(1);
    if (IN(2)) { pg8::Gemm g{Hb, W1T, MTOK, NP1, DM}; pg8::StaticOrder S; S.init(MTOK, NP1, G, (int)blockIdx.x);
        pg8::EpiStore E{PRKV, PSB, PLORA, 12, 24, 3072, 3072, 768};
        pg8::gemm_phase<pg8::EpiStore, pg8::StaticOrder, true, true>(lds, g, S, E); }
    SEAM(2);
    if (IN(3)) { PHASE_IDS();
        for (int it0 = gtid; it0 < MTOK * 48; it0 += 2 * NGT) {
            u32x4 ua[2], ub[2]; int tt[2], jj[2]; bool ok[2];
#pragma unroll
            for (int e = 0; e < 2; ++e) { const int it = it0 + e * NGT; ok[e] = it < MTOK * 48; tt[e] = it / 48; jj[e] = it % 48; ua[e] = (u32x4){0u, 0u, 0u, 0u}; ub[e] = ua[e];
                if (ok[e] && jj[e] < 36) { ua[e] = *(const u32x4*)(PLORA + (size_t)tt[e] * 768 + 8 * jj[e]);
                    if ((tt[e] & (SEQ - 1)) != 0) ub[e] = *(const u32x4*)(PLORA + (size_t)(tt[e] - 1) * 768 + NLORA + 8 * jj[e]); } }
#pragma unroll
            for (int e = 0; e < 2; ++e) { if (!ok[e]) continue; const int j = jj[e]; u32x4 o = {0u, 0u, 0u, 0u};
                if (j < 36) { const unsigned a4[4] = {ua[e].x, ua[e].y, ua[e].z, ua[e].w}, b4[4] = {ub[e].x, ub[e].y, ub[e].z, ub[e].w}; unsigned r4[4];
#pragma unroll
                    for (int q = 0; q < 4; ++q) { float v0 = bflo(a4[q]) + bflo(b4[q]), v1 = bfhi(a4[q]) + bfhi(b4[q]);
                        if (j < 8) { v0 = 1.0f - 2.0f * frcp(1.0f + fexp2(2.0f * LOG2E * v0)); v1 = 1.0f - 2.0f * frcp(1.0f + fexp2(2.0f * LOG2E * v1)); }
                        else if (j >= 16) { v0 = sigmoidf_(v0); v1 = sigmoidf_(v1); }
                        r4[q] = pk2(v0, v1); }
                    o = (u32x4){r4[0], r4[1], r4[2], r4[3]}; }
                *(u32x4*)(HID + (size_t)tt[e] * KH + 8 * j) = o; } } }
    SEAM(3);
    if (IN(4)) {
        { pg8::Gemm g{HID, W2T, MTOK, 2048, 256, KH, KH}; pg8::StaticOrder S; S.init(MTOK, 2048, G, (int)blockIdx.x);
          pg8::EpiStore E{L2O, L2O, L2O, 1000, 1000, 3072, 3072, 3072};
          pg8::gemm_phase<pg8::EpiStore, pg8::StaticOrder, true, true>(lds, g, S, E); }
        { pg8::Gemm g{HID + 128, W2T + (size_t)2048 * KH + 128, MTOK, 1024, 256, KH, KH}; pg8::StaticOrder S; S.init(MTOK, 1024, G, (int)blockIdx.x);
          pg8::EpiStore E{L2O + 2048, L2O + 2048, L2O + 2048, 1000, 1000, 3072, 3072, 3072};
          pg8::gemm_phase<pg8::EpiStore, pg8::StaticOrder, true, true>(lds, g, S, E); } }
    SEAM(4);
    if (IN(5)) { PHASE_IDS();
        { const PrepPtrs PP{PRKV, L2O, SR, SKT, SWR, SREM, SV, BS, args.in[7], args.in[11], args.in[14], args.in[19], args.in[20], args.in[21]};
          rwkv_prep(PP, gw, NGW, lane, (G >= 256) ? 0 : 2); }
    }
    SEAM(5);
    if (IN(6)) { PHASE_IDS();
        { ScanPtrs SP{SR, SKT, SWR, SREM, SV, L2O};
          const bool split = (G >= 256);
          const int sstride = split ? 128 : G;
          if (!split || blockIdx.x < 128)
              for (int rep = 0; rep < (PROBE == 1 ? 2 : 1); ++rep) for (int item = blockIdx.x; item < 128; item += sstride) { scan_item(lds, SP, YC, item, hcnt, split ? (unsigned)(G - 128) : 0u); __syncthreads(); }
          if (!split || blockIdx.x >= 128) { const int ablk = split ? (int)blockIdx.x - 128 : (int)blockIdx.x, astride = split ? G - 128 : G;
              if (split) {
                  const PrepPtrs PP{PRKV, L2O, SR, SKT, SWR, SREM, SV, BS, args.in[7], args.in[11], args.in[14], args.in[19], args.in[20], args.in[21]};
                  rwkv_prep(PP, ablk * 8 + wave, astride * 8, lane, 1);
                  asm volatile("s_waitcnt vmcnt(0)" ::: "memory"); __syncthreads();
                  if (threadIdx.x == 0) { __builtin_amdgcn_fence(__ATOMIC_RELEASE, "agent"); asm volatile("s_waitcnt vmcnt(0)" ::: "memory"); xb_add(hcnt, 1u); }
                  __syncthreads(); }
              for (int rep = 0; rep < (PROBE == 2 ? 2 : 1); ++rep) for (int u = ablk; u < 1024; u += astride) { sb_attn_unit(lds, PSB, YC, args.in[24], args.in[25], u >> 8, (u >> 4) & 15, u & 15); __syncthreads(); }
              if (split) { late_weight_copies(args.in[26], args.in[27], args.in[28], WOT, WGUT, WDT, (LAS float*)(lds + wave * 16384), lane, ablk * 8 + wave, astride * 8);
                  sh2_gemv(mod, args.in[27], c2v, ablk * 512 + tid, astride * 512); } } }
    }
    SEAM(6);
    if (IN(7)) { PHASE_IDS(); const int q4 = gw & 3, c = 256 * q4 + 4 * lane;
        const f32x4 lng = *(const f32x4*)(args.in[22] + c), lnb = *(const f32x4*)(args.in[23] + c);
        const int head = 4 * q4 + (lane >> 4);
        for (int tg = gw >> 2; tg < MTOK / 8; tg += NGW >> 2) {
            u32x2 ly[8], lv[8], lg[8]; float lb[8];
            const int t0 = 8 * tg;
#pragma unroll
            for (int i = 0; i < 8; ++i) { const int t = t0 + i;
                ly[i] = *(const u32x2*)(YC + (size_t)t * 2048 + c); lv[i] = *(const u32x2*)(SV + (size_t)t * DR + c); lg[i] = *(const u32x2*)(L2O + (size_t)t * 3072 + 2 * DR + c); lb[i] = BS[(size_t)t * 16 + head]; }
#pragma unroll
            for (int i = 0; i < 8; ++i) { const int t = t0 + i;
                const f32x4 y = bf4(ly[i]), v = bf4(lv[i]), gg = bf4(lg[i]);
                const float mean = allsum16((y[0] + y[1]) + (y[2] + y[3])) * (1.0f / 64.0f);
                const f32x4 dy = y - mean; const float var = allsum16((dy[0] * dy[0] + dy[1] * dy[1]) + (dy[2] * dy[2] + dy[3] * dy[3])) * (1.0f / 64.0f);
                const f32x4 o = (dy * __builtin_amdgcn_rsqf(var + 64e-5f) * lng + lnb + v * lb[i]) * gg;
                *(u32x2*)(YC + (size_t)t * 2048 + c) = pk4(o); } } }
    SEAM(7);
    if (IN(8)) { pg8::Gemm g{YC, WOT, MTOK, DM, DM}; pg8::StaticOrder S; S.init(MTOK, DM, G, (int)blockIdx.x);
        pg8::EpiResH2 E{x, out, mod, args.in[5], H2, rowss};
        pg8::gemm_phase<pg8::EpiResH2, pg8::StaticOrder, true, true>(lds, g, S, E); }
    SEAM(8);
    SEAM(9);
    if (IN(10)) { pg8::Gemm g{H2, WGUT, MTOK, 2 * DFF, DM}; pg8::StaticOrder S; S.init(MTOK, 2 * DFF, G, (int)blockIdx.x);
        pg8::EpiSwiGLU E{ACT, rowss, c2v};
        for (int rep = 0; rep < (PROBE == 4 ? 2 : 1); ++rep) pg8::gemm_phase<pg8::EpiSwiGLU, pg8::StaticOrder, true, true>(lds, g, S, E); }
    SEAM(10);
    if (IN(11)) { pg8::Gemm g{ACT, WDT, MTOK, DM, DFF}; pg8::StaticOrder S; S.init(MTOK, DM, G, (int)blockIdx.x);
        pg8::EpiRes E{out, out, mod + 5 * DM};
        pg8::gemm_phase<pg8::EpiRes, pg8::StaticOrder, true, true>(lds, g, S, E); }
#undef IN
#undef SEAM
}

#ifndef MK_N_LAUNCHES
#define MK_N_LAUNCHES 1
#endif
extern "C" void kernel_launch(void* const* d_in, const int* in_sizes, int n_in, void* d_out, int out_size, void* d_ws, size_t ws_size, hipStream_t stream) {
    static int grid = 0;
    if (grid == 0) {
        if (n_in != 29 || in_sizes[0] != MTOK * DM || out_size != MTOK * DM || ws_size < WS_END) { fprintf(stderr, "kernel_launch: unexpected shapes / workspace (n_in %d, ws %zu, need %zu)\n", n_in, ws_size, (size_t)WS_END); grid = -1; return; }
        int dev = 0, cus = 0, per_cu = 0;
        if (hipGetDevice(&dev) != hipSuccess || hipDeviceGetAttribute(&cus, hipDeviceAttributeMultiprocessorCount, dev) != hipSuccess) { grid = -1; return; }
        if (hipFuncSetAttribute((const void*)mk_fwd, hipFuncAttributeMaxDynamicSharedMemorySize, LDS_BYTES) != hipSuccess) { fprintf(stderr, "kernel_launch: hipFuncSetAttribute failed\n"); grid = -1; return; }
        if (hipOccupancyMaxActiveBlocksPerMultiprocessor(&per_cu, (const void*)mk_fwd, 512, LDS_BYTES) != hipSuccess || per_cu < 1) { fprintf(stderr, "kernel_launch: occupancy query says %d blocks per CU\n", per_cu); per_cu = 1; }
        (void)hipGetLastError();
        grid = cus;
    }
    if (grid < 0) return;
    (void)hipMemsetAsync((char*)d_ws + WS_CTL, 0, CTL_ZERO_BYTES, stream);
    Args a{};
    for (int i = 0; i < 29; ++i) a.in[i] = (const float*)d_in[i];
    a.out = (float*)d_out; a.ws = (unsigned char*)d_ws;
#if MK_N_LAUNCHES == 1
    a.ph_lo = 0; a.ph_hi = N_PHASES;
    void* kargs[] = {&a};
    hipError_t e = hipLaunchCooperativeKernel((const void*)mk_fwd, dim3(grid), dim3(512), kargs, LDS_BYTES, stream);
    if (e != hipSuccess) fprintf(stderr, "cooperative launch failed: %s (grid %d)\n", hipGetErrorString(e), grid);
#else
    for (int p = 0; p < N_PHASES; ++p) { a.ph_lo = p; a.ph_hi = p + 1; hipLaunchKernelGGL(mk_fwd, dim3(grid), dim3(512), LDS_BYTES, stream, a); }
#endif
}
```
